# Optimizing an MI355X kernel written in HIP

```python
import jax, jax.numpy as jnp
from jax import lax
import numpy as np

D_MODEL = 1024
BATCH = 16
SEQ = 2048
DEPTH = 1

CHUNK = 64
HEAD_DIM = 64
SB_WIDTH = D_MODEL // 2
N_SB_HEADS = SB_WIDTH // HEAD_DIM
POOL_WINDOWS = (2, 4, 8, 16)
N_POOL_GROUPS = len(POOL_WINDOWS)
POOL_WIDTH = D_MODEL // 2
POOL_GROUP_DIM = POOL_WIDTH // N_POOL_GROUPS
N_BRANCHES = 2
MIX_PROJ_WIDTH = 3 * SB_WIDTH + POOL_WIDTH + N_BRANCHES * D_MODEL
Q_BLOCK = 128
N_EXPERT_GROUPS = 4
EXPERTS_PER_GROUP = 8
N_EXPERTS = N_EXPERT_GROUPS * EXPERTS_PER_GROUP
TOP_K_INNER = 2
D_EXPERT = D_MODEL // 2
MOE_BLOCK = 256
N_MOD = 6
EPS = 1e-6

kernel_name = 'hybrid_stickbreak_pool_hmoe_block'


def rms_norm(x, g):
    xf = x.astype(jnp.float32)
    y = xf * lax.rsqrt(jnp.mean(xf * xf, axis=-1, keepdims=True) + EPS)
    return (y * g.astype(jnp.float32)).astype(x.dtype)


def modulate(h, shift, scale):
    return h * (1.0 + scale[:, None, :]) + shift[:, None, :]


def stick_breaking_attention(q, k, v):
    seq = q.shape[2]
    inv_sqrt_d = HEAD_DIM ** -0.5
    outs = []
    for blk in range(seq // Q_BLOCK):
        q0 = blk * Q_BLOCK
        kv = q0 + Q_BLOCK
        z = jnp.einsum('bhtd,bhsd->bhts', q[:, :, q0:kv], k[:, :, :kv]).astype(jnp.float32) * inv_sqrt_d
        t_pos = q0 + jnp.arange(Q_BLOCK)[:, None]
        s_pos = jnp.arange(kv)[None, :]
        past = s_pos < t_pos
        log_stay = jnp.where(past, jax.nn.log_sigmoid(-z), 0.0)
        log_between = lax.cumsum(log_stay, axis=3, reverse=True) - log_stay
        a = jnp.where(past, jnp.exp(jax.nn.log_sigmoid(z) + log_between), 0.0)
        outs.append(jnp.einsum('bhts,bhsd->bhtd', a.astype(v.dtype), v[:, :, :kv]))
    return jnp.concatenate(outs, axis=2)


def multiscale_pool(p):
    b, s, _ = p.shape
    pg = p.reshape(b, s, N_POOL_GROUPS, POOL_GROUP_DIM).astype(jnp.float32)
    cs = jnp.concatenate([jnp.zeros((b, 1, N_POOL_GROUPS, POOL_GROUP_DIM), jnp.float32),
                          jnp.cumsum(pg, axis=1)], axis=1)
    t = jnp.arange(s)
    outs = []
    for g, w in enumerate(POOL_WINDOWS):
        lo = jnp.maximum(t + 1 - w, 0)
        win_sum = cs[:, 1:, g] - cs[:, lo, g]
        count = (t + 1 - lo).astype(jnp.float32)
        outs.append(win_sum / count[None, :, None])
    pooled = jnp.stack(outs, axis=2)
    return (pooled - pg).astype(p.dtype)


def hybrid_mixer(h, w_in, pool_w, pool_scale, w_branch_sb, w_branch_pool, w_out):
    b, s, _ = h.shape
    proj = h @ w_in
    q, k, v, p, gate_sb, gate_pool = jnp.split(
        proj, [SB_WIDTH, 2 * SB_WIDTH, 3 * SB_WIDTH, 3 * SB_WIDTH + POOL_WIDTH,
               3 * SB_WIDTH + POOL_WIDTH + D_MODEL], axis=-1)

    def heads(a):
        return a.reshape(b, s, N_SB_HEADS, HEAD_DIM).transpose(0, 2, 1, 3)

    o_sb = stick_breaking_attention(heads(q), heads(k), heads(v))
    o_sb = o_sb.transpose(0, 2, 1, 3).reshape(b, s, SB_WIDTH)

    pooled = multiscale_pool(p).reshape(b, s, N_POOL_GROUPS, POOL_GROUP_DIM)
    o_pool = jnp.einsum('bsgc,gcd->bsgd', pooled, pool_w).reshape(b, s, POOL_WIDTH) * pool_scale

    merged = (jax.nn.sigmoid(gate_sb) * (o_sb @ w_branch_sb)
              + jax.nn.sigmoid(gate_pool) * (o_pool @ w_branch_pool))
    return merged @ w_out


def hierarchical_moe(h, w_rg, b_rg, w_re, b_re, w_gate, w_up, w_down):
    b, s, d = h.shape
    n = b * s
    t = h.reshape(n, d)
    rows = jnp.arange(n)
    grp_logits = (t @ w_rg).astype(jnp.float32) + b_rg.astype(jnp.float32)
    grp_prob = jax.nn.softmax(grp_logits, axis=-1)
    _, gsel = lax.top_k(grp_logits, 1)
    p_group = grp_prob[rows, gsel[:, 0]]
    exp_logits = jnp.einsum('nd,gde->nge', t, w_re).astype(jnp.float32) + b_re.astype(jnp.float32)
    in_group = exp_logits[rows, gsel[:, 0]]
    top_val, top_idx = lax.top_k(in_group, TOP_K_INNER)
    combine = p_group[:, None] * jax.nn.softmax(top_val, axis=-1)
    expert_id = gsel * EXPERTS_PER_GROUP + top_idx

    nk = n * TOP_K_INNER
    flat_e = expert_id.reshape(nk)
    flat_tok = jnp.repeat(rows, TOP_K_INNER)
    flat_w = combine.reshape(nk)
    order = jnp.argsort(flat_e)
    sorted_e = flat_e[order]
    counts = jnp.zeros((N_EXPERTS,), jnp.int32).at[flat_e].add(1)
    padded = ((counts + MOE_BLOCK - 1) // MOE_BLOCK) * MOE_BLOCK
    pad_end = jnp.cumsum(padded)
    pad_start = pad_end - padded
    start = jnp.cumsum(counts) - counts
    dest = pad_start[sorted_e] + (jnp.arange(nk) - start[sorted_e])
    n_slots = ((nk + MOE_BLOCK - 1) // MOE_BLOCK + N_EXPERTS) * MOE_BLOCK
    n_blocks = n_slots // MOE_BLOCK
    slot_tok = jnp.zeros((n_slots,), jnp.int32).at[dest].set(flat_tok[order])
    slot_w = jnp.zeros((n_slots,), flat_w.dtype).at[dest].set(flat_w[order])
    block_e = jnp.minimum(jnp.searchsorted(pad_end, jnp.arange(n_blocks) * MOE_BLOCK, side='right'),
                          N_EXPERTS - 1)
    xs = t[slot_tok].reshape(n_blocks, MOE_BLOCK, d)

    def expert_block(args):
        xb, e = args
        return (jax.nn.silu(xb @ w_gate[e]) * (xb @ w_up[e])) @ w_down[e]

    ys = lax.map(expert_block, (xs, block_e)).reshape(n_slots, d)
    out = jnp.zeros((n, d), t.dtype).at[slot_tok].add(ys * slot_w[:, None].astype(t.dtype))
    return out.reshape(b, s, d)


def setup_inputs(seed: int = 0) -> dict:
    key = jax.random.key(seed)
    ks = jax.random.split(key, 20)
    f32 = jnp.float32

    def nrm(k, shape, scale):
        return jax.random.normal(k, shape, f32) * scale

    L = DEPTH
    return {
        'x': nrm(ks[0], (BATCH, SEQ, D_MODEL), 1.0),
        'c': nrm(ks[1], (BATCH, D_MODEL), 1.0),
        'norm1_g': 1.0 + nrm(ks[2], (L, D_MODEL), 0.05),
        'norm2_g': 1.0 + nrm(ks[3], (L, D_MODEL), 0.05),
        'w_ada': nrm(ks[4], (L, D_MODEL, N_MOD * D_MODEL), 0.5 * D_MODEL ** -0.5),
        'b_ada': nrm(ks[5], (L, N_MOD * D_MODEL), 0.01),
        'w_in': nrm(ks[6], (L, D_MODEL, MIX_PROJ_WIDTH), D_MODEL ** -0.5),
        'pool_w': nrm(ks[7], (L, N_POOL_GROUPS, POOL_GROUP_DIM, POOL_GROUP_DIM), POOL_GROUP_DIM ** -0.5),
        'pool_scale': 1.0 + nrm(ks[8], (L, POOL_WIDTH), 0.1),
        'w_branch_sb': nrm(ks[9], (L, SB_WIDTH, D_MODEL), SB_WIDTH ** -0.5),
        'w_branch_pool': nrm(ks[10], (L, POOL_WIDTH, D_MODEL), POOL_WIDTH ** -0.5),
        'w_out': nrm(ks[11], (L, D_MODEL, D_MODEL), D_MODEL ** -0.5),
        'w_route_group': nrm(ks[12], (L, D_MODEL, N_EXPERT_GROUPS), D_MODEL ** -0.5),
        'b_route_group': nrm(ks[13], (L, N_EXPERT_GROUPS), 0.01),
        'w_route_expert': nrm(ks[14], (L, N_EXPERT_GROUPS, D_MODEL, EXPERTS_PER_GROUP), D_MODEL ** -0.5),
        'b_route_expert': nrm(ks[15], (L, N_EXPERT_GROUPS, EXPERTS_PER_GROUP), 0.01),
        'w_exp_gate': nrm(ks[16], (L, N_EXPERTS, D_MODEL, D_EXPERT), D_MODEL ** -0.5),
        'w_exp_up': nrm(ks[17], (L, N_EXPERTS, D_MODEL, D_EXPERT), D_MODEL ** -0.5),
        'w_exp_down': nrm(ks[18], (L, N_EXPERTS, D_EXPERT, D_MODEL), D_EXPERT ** -0.5),
        'norm_f_g': 1.0 + nrm(ks[19], (D_MODEL,), 0.05),
    }


def reference(x, c, norm1_g, norm2_g, w_ada, b_ada, w_in, pool_w, pool_scale,
              w_branch_sb, w_branch_pool, w_out, w_route_group, b_route_group,
              w_route_expert, b_route_expert, w_exp_gate, w_exp_up, w_exp_down, norm_f_g):
    c_act = jax.nn.silu(c)
    for layer in range(DEPTH):
        mods = c_act @ w_ada[layer] + b_ada[layer]
        shift1, scale1, gate1, shift2, scale2, gate2 = jnp.split(mods, N_MOD, axis=-1)
        h = modulate(rms_norm(x, norm1_g[layer]), shift1, scale1)
        x = x + gate1[:, None, :] * hybrid_mixer(
            h, w_in[layer], pool_w[layer], pool_scale[layer],
            w_branch_sb[layer], w_branch_pool[layer], w_out[layer])
        h = modulate(rms_norm(x, norm2_g[layer]), shift2, scale2)
        x = x + gate2[:, None, :] * hierarchical_moe(
            h, w_route_group[layer], b_route_group[layer], w_route_expert[layer],
            b_route_expert[layer], w_exp_gate[layer], w_exp_up[layer], w_exp_down[layer])
    return rms_norm(x, norm_f_g)
```

```cpp
#include <hip/hip_runtime.h>
#include <cstdint>
#include <cstdio>
typedef _Float16 h16;
#define GAS __attribute__((address_space(1)))
#define LAS __attribute__((address_space(3)))
typedef unsigned u32x4 __attribute__((ext_vector_type(4)));
typedef unsigned u32x2 __attribute__((ext_vector_type(2)));
typedef float f32x4 __attribute__((ext_vector_type(4)));
typedef float f32x16 __attribute__((ext_vector_type(16)));
typedef _Float16 f16x8 __attribute__((ext_vector_type(8)));
typedef _Float16 f16x4 __attribute__((ext_vector_type(4)));
typedef _Float16 f16x2 __attribute__((ext_vector_type(2)));
typedef GAS unsigned gu32;

constexpr int NB = 16, SEQ = 2048, DM = 1024, M = NB * SEQ, NH = 8, HD = 64, PW = 512, NPROJ = 4096;
constexpr int NEXP = 32, DE = 512, LISTCAP = 32768, NMODS = 6144;
constexpr float C2 = 0.125f * 1.4426950408889634f;
constexpr float EPS = 1e-6f;
constexpr float L2E = 1.4426950408889634f;
constexpr float EXIT_L2 = -152.0f;

constexpr size_t MiB = 1u << 20;
constexpr size_t WS_CTL = 0, CTL_ZERO_BYTES = 2 * MiB;
constexpr size_t WS_MODS = 1 * MiB, WS_EID = 2 * MiB, WS_CW = 2 * MiB + 256 * 1024, WS_POS = 2 * MiB + 512 * 1024;
constexpr size_t WS_LIST = 4 * MiB;
constexpr size_t WS_WIN = 392 * MiB, WS_WBSB = 400 * MiB, WS_WBEFF = 401 * MiB, WS_WOUT = 402 * MiB, WS_WR = 404 * MiB, WS_WUP = 408 * MiB, WS_WDN = 472 * MiB;
constexpr size_t WS_RA = 328 * MiB;
constexpr size_t WS_Q = 8 * MiB, WS_K = 40 * MiB, WS_V = 72 * MiB, WS_P = 104 * MiB;
constexpr size_t WS_SGS = 136 * MiB, WS_SGP = 200 * MiB;
constexpr size_t WS_OSB = 264 * MiB, WS_POOLED = 296 * MiB;
constexpr size_t WS_CAT = 264 * MiB;
constexpr size_t WS_WCAT = 400 * MiB;
constexpr size_t WS_X1 = 264 * MiB;
constexpr size_t WS_Y = 8 * MiB, WS_H = 152 * MiB;
constexpr size_t WS_END = 504 * MiB;
constexpr int CW_TMO = 0;
constexpr int CW_GCNT = 1024;
constexpr int CW_MODS = 3584;
constexpr int CW_BAR = 4096;
constexpr int CTL_ZERO_WORDS = 8192;
constexpr int CW_FLAGS = 16384;
constexpr unsigned INIT_MAGIC = 0x5EED1234u;
constexpr int RING_BYTES = 131072, MISC_OFF = 147456, LDS_BYTES = 155648;
constexpr int NWAVES = 8;

#define RLX_AGENT __ATOMIC_RELAXED, __HIP_MEMORY_SCOPE_AGENT

#define LDS_WAIT() asm volatile("s_waitcnt lgkmcnt(0)" ::: "memory")
#define VM_WAIT() asm volatile("s_waitcnt vmcnt(0)" ::: "memory")

__device__ __forceinline__ float wave_sum(float v) {
#pragma unroll
    for (int o = 1; o < 64; o <<= 1) v += __shfl_xor(v, o);
    return v;
}
__device__ __forceinline__ unsigned pk_h2(float lo, float hi) { f16x2 v = {(_Float16)lo, (_Float16)hi}; return __builtin_bit_cast(unsigned, v); }
__device__ __forceinline__ float fast_sigmoid(float v) { return __builtin_amdgcn_rcpf(1.f + __builtin_amdgcn_exp2f(-v * L2E)); }

#define XB_TMO      128
#define XB_XCNT(j)  (256  + 64 * (j))
#define XB_XSUB(j)  (1280 + 64 * (j))
#define XB_XGEN(j)  (2304 + 64 * (j))
#define XB_TOP      3328
#define XB_TOPGEN   3392
#define XCD_BAR_WORDS 3456
#define XB_SPIN_CAP (1u << 18)
__device__ __forceinline__ unsigned xb_ld(unsigned* p)              { return __hip_atomic_load(p, __ATOMIC_RELAXED, __HIP_MEMORY_SCOPE_AGENT); }
__device__ __forceinline__ unsigned xb_add(unsigned* p, unsigned v) { return __hip_atomic_fetch_add(p, v, __ATOMIC_RELAXED, __HIP_MEMORY_SCOPE_AGENT); }
__device__ __forceinline__ unsigned xb_xcc_id() { return (unsigned)__builtin_amdgcn_s_getreg((3 << 11) | 20) & 0xFu; }
#define XB_SPIN(cond, bar) do { unsigned _sp = 0; while (cond) { __builtin_amdgcn_s_sleep(1); \
    if ((++_sp & 255u) == 0u) { if (xb_ld(&(bar)[XB_TMO])) break; if (_sp > XB_SPIN_CAP) { atomicAdd(&(bar)[XB_TMO], 1u); break; } } } } while (0)
struct XcdBarrier { unsigned* bar; unsigned x; volatile LAS unsigned* st; };
__device__ __forceinline__ XcdBarrier xcd_barrier_post(unsigned* bar, volatile LAS unsigned* st) {
    XcdBarrier b; b.bar = bar; b.x = xb_xcc_id(); b.st = st;
    return b;
}
__device__ __forceinline__ void xcd_barrier_register(const XcdBarrier& b) { if (threadIdx.x == 0) (void)xb_add(&b.bar[XB_XCNT(b.x)], 1u); }
__device__ __forceinline__ void xcd_barrier_complete(unsigned* bar, unsigned x, unsigned& nloc, unsigned& nx) {
    const unsigned G = gridDim.x * gridDim.y * gridDim.z;
    unsigned sum, cnt, mine, sp = 0u;
    for (;;) {
        sum = 0u; cnt = 0u; mine = 0u;
#pragma unroll
        for (unsigned j = 0; j < 16; ++j) { const unsigned c = xb_ld(&bar[XB_XCNT(j)]); sum += c; cnt += (c > 0u) ? 1u : 0u; mine = (j == x) ? c : mine; }
        if (sum == G) break;
        __builtin_amdgcn_s_sleep(1);
        if ((++sp & 255u) == 0u) { if (xb_ld(&bar[XB_TMO])) break; if (sp > XB_SPIN_CAP) { atomicAdd(&bar[XB_TMO], 1u); break; } }
    }
    nloc = mine > 0u ? mine : 1u; nx = cnt > 0u ? cnt : 1u;
}
__device__ __forceinline__ void xcd_barrier(const XcdBarrier& b) {
    asm volatile("s_waitcnt vmcnt(0)" ::: "memory");
    __syncthreads();
    if (threadIdx.x == 0) {
        unsigned* bar = b.bar;
        __builtin_amdgcn_s_waitcnt(0);
        unsigned nloc = b.st[0], nx = b.st[1];
        if (nloc == 0u) { xcd_barrier_complete(bar, b.x, nloc, nx); b.st[0] = nloc; b.st[1] = nx; }
        const unsigned old = xb_add(&bar[XB_XSUB(b.x)], 1u);
        const unsigned gen = old / nloc;
        if (old + 1u == (gen + 1u) * nloc) {
            __builtin_amdgcn_fence(__ATOMIC_RELEASE, "agent");
            asm volatile("s_waitcnt vmcnt(0)" ::: "memory");
            const unsigned og = xb_add(&bar[XB_TOP], 1u);
            const unsigned tg = og / nx;
            if (og + 1u == (tg + 1u) * nx) xb_add(&bar[XB_TOPGEN], 1u);
            else XB_SPIN(xb_ld(&bar[XB_TOPGEN]) == tg, bar);
            __builtin_amdgcn_fence(__ATOMIC_ACQUIRE, "agent");
            xb_add(&bar[XB_XGEN(b.x)], 1u);
            asm volatile("s_waitcnt vmcnt(0)" ::: "memory");
        } else {
            XB_SPIN(xb_ld(&bar[XB_XGEN(b.x)]) == gen, bar);
            __builtin_amdgcn_fence(__ATOMIC_ACQUIRE, "agent");
            asm volatile("s_waitcnt vmcnt(0)" ::: "memory");
        }
    }
    __syncthreads();
}
namespace g8 {
#define G8_LAS __attribute__((address_space(3)))
typedef _Float16 f16x8 __attribute__((ext_vector_type(8)));
typedef float f32x4 __attribute__((ext_vector_type(4)));
typedef unsigned u32x4 __attribute__((ext_vector_type(4)));
typedef unsigned u32x2 __attribute__((ext_vector_type(2)));
typedef _Float16 f16x2 __attribute__((ext_vector_type(2)));
constexpr int BM = 256, BK = 64, HALF = 128, HTB = HALF * BK * 2  , STAGE_BYTES = 8 * HTB;

__host__ __device__ __forceinline__ int lds_byte(int r, int c) { const int st = (r >> 4) * 2 + (c >> 5), rr = r & 15, cc = c & 31, ob = rr * 64 + cc * 2; return st * 1024 + (ob ^ (((ob >> 9) & 1) << 5)); }
__host__ __device__ __forceinline__ void stage_rc(int b, int& R, int& C) { const int st = b / 1024, sb = b % 1024, swz = sb ^ (((sb >> 9) & 1) << 5); R = (st >> 1) * 16 + swz / 64; C = (st & 1) * 32 + (swz % 64) / 2; }
__host__ __device__ __forceinline__ int perm32(int rho) { const int n = rho >> 4, i = rho & 15; return 8 * (i >> 2) + 4 * n + (i & 3); }

__device__ __forceinline__ unsigned pk_h2(float lo, float hi) { f16x2 v = {(_Float16)lo, (_Float16)hi}; return __builtin_bit_cast(unsigned, v); }

struct Unit {
    unsigned aoff[2][2];
    const char* Ab;
    const char* Bb;
    int orow;
    int pn;
    int aux;
};

template <class Epi, class Sched>
__device__ __forceinline__ void gemm_phase(G8_LAS unsigned char* lds, const char* Abase, const int K, const int LD, Sched& S, const Epi& E) {
    const int tid = threadIdx.x, wid = __builtin_amdgcn_readfirstlane(tid >> 6), lane = tid & 63, wr = wid >> 2, wc = wid & 3, fr = lane & 15, fq = lane >> 4;
    const int nt = K / BK;
    unsigned voffB[2], voffA[2][2];
#pragma unroll
    for (int i = 0; i < 2; ++i) { int R, C; stage_rc(tid * 16 + i * 8192, R, C); const int Rb = Epi::PERM ? ((R & ~31) + perm32(R & 31)) : R; voffB[i] = (unsigned)(Rb * LD + C) * 2u;
        voffA[0][i] = (unsigned)(R * LD + C) * 2u; voffA[1][i] = (unsigned)((R + HALF) * LD + C) * 2u; }
    constexpr bool GA = Sched::GATHER, HS = Sched::HALFABLE;
    const size_t kstep = (size_t)(BK * 2);
    const size_t hstep = (size_t)HALF * LD * 2;
    const unsigned ldsw = (unsigned)wid * 1024u;
    const int aoff = lds_byte(wr * 64 + fr, fq * 8), boff = lds_byte(wc * 32 + fr, fq * 8);
#define G8_SA(b, h) (((b) * 2 + (h)) * HTB)
#define G8_SB(b, h) ((4 + (b) * 2 + (h)) * HTB)
#define G8_STAGE(bufoff, gbase, voff) do { _Pragma("unroll") for (int _i = 0; _i < 2; ++_i) \
        __builtin_amdgcn_global_load_lds((const unsigned*)((const char*)(gbase) + (voff)[_i]), (G8_LAS unsigned*)(lds + (bufoff) + ldsw + _i * 8192), 16, 0, 0); } while (0)
#define G8_LDA(dst, b, h) do { _Pragma("unroll") for (int m = 0; m < 4; ++m) _Pragma("unroll") for (int k = 0; k < 2; ++k) dst[m][k] = *(const G8_LAS f16x8*)(lds + G8_SA(b, h) + aoff + m * 2048 + k * 1024); } while (0)
#define G8_LDB(dst, b, h) do { _Pragma("unroll") for (int n = 0; n < 2; ++n) _Pragma("unroll") for (int k = 0; k < 2; ++k) dst[n][k] = *(const G8_LAS f16x8*)(lds + G8_SB(b, h) + boff + n * 2048 + k * 1024); } while (0)
#define G8_MMA(ai, bj, At, Bt) do { __builtin_amdgcn_s_setprio(1); _Pragma("unroll") for (int m = 0; m < 4; ++m) _Pragma("unroll") for (int n = 0; n < 2; ++n) _Pragma("unroll") for (int k = 0; k < 2; ++k) \
        acc[ai][bj][m][n] = __builtin_amdgcn_mfma_f32_16x16x32_f16(Bt[n][k], At[m][k], acc[ai][bj][m][n], 0, 0, 0); __builtin_amdgcn_s_setprio(0); } while (0)
#define G8_WAIT_V(n) asm volatile("s_waitcnt vmcnt(" #n ")" ::: "memory")
#define G8_WAIT_L(n) asm volatile("s_waitcnt lgkmcnt(" #n ")" ::: "memory")
#define G8_BAR __builtin_amdgcn_s_barrier()
#define G8_SCHED __builtin_amdgcn_sched_barrier(0)
    Unit cur, nxt; int ui = 0;
    if (!S.next(0, cur)) return;
    f32x4 acc[2][2][4][2];
#pragma unroll
    for (int a = 0; a < 2; ++a)
#pragma unroll
        for (int b = 0; b < 2; ++b)
#pragma unroll
            for (int m = 0; m < 4; ++m)
#pragma unroll
                for (int n = 0; n < 2; ++n) acc[a][b][m][n] = (f32x4){0.f, 0.f, 0.f, 0.f};
    f16x8 At[4][2], B0[2][2], B1[2][2];
    G8_STAGE(G8_SB(0, 0), cur.Bb, voffB); G8_STAGE(G8_SB(0, 1), cur.Bb + hstep, voffB); G8_STAGE(G8_SA(0, 0), (GA ? Abase : cur.Ab), (GA ? cur.aoff[0] : voffA[0])); G8_STAGE(G8_SA(0, 1), (GA ? Abase : cur.Ab), (GA ? cur.aoff[1] : voffA[1]));
    if (wr == 1) G8_BAR;
    G8_WAIT_V(2); G8_BAR;
    G8_STAGE(G8_SB(1, 0), cur.Bb + kstep, voffB); G8_STAGE(G8_SA(1, 0), (GA ? Abase : cur.Ab) + kstep, (GA ? cur.aoff[0] : voffA[0])); G8_STAGE(G8_SB(1, 1), cur.Bb + hstep + kstep, voffB);
    G8_WAIT_V(6); G8_BAR;
    for (;;) {
        const bool has_next = S.next(ui + 1, nxt);
        if (!has_next) nxt = cur;
        for (int t = 0; t < nt; t += 2) {
            const bool last = (t == nt - 2);
            const char* cAb = GA ? Abase : cur.Ab; const char* nAb = GA ? Abase : nxt.Ab;
            const char* a1 = cAb + (size_t)(t + 1) * kstep;
            const char* a2 = last ? nAb : cAb + (size_t)(t + 2) * kstep;
            const char* b2 = last ? nxt.Bb : cur.Bb + (size_t)(t + 2) * kstep;
            const char* a3 = a2 + kstep; const char* b3 = b2 + kstep;
            unsigned o2[2][2];
#pragma unroll
            for (int h = 0; h < 2; ++h)
#pragma unroll
                for (int i = 0; i < 2; ++i) o2[h][i] = GA ? (last ? nxt.aoff[h][i] : cur.aoff[h][i]) : voffA[h][i];
            G8_LDB(B0, 0, 0); G8_LDB(B1, 0, 1); G8_SCHED; G8_LDA(At, 0, 0); G8_STAGE(G8_SA(1, 1), a1, (GA ? cur.aoff[1] : voffA[1]));
            G8_WAIT_V(8); G8_WAIT_L(0); G8_BAR; G8_MMA(0, 0, At, B0); G8_MMA(0, 1, At, B1); G8_BAR; G8_SCHED;
            if (!HS || !(cur.aux & 256)) { G8_LDA(At, 0, 1); } G8_STAGE(G8_SB(0, 0), b2, voffB); G8_STAGE(G8_SB(0, 1), b2 + hstep, voffB); G8_STAGE(G8_SA(0, 0), a2, o2[0]);
            G8_WAIT_V(8); G8_WAIT_L(0); G8_BAR; if (!HS || !(cur.aux & 256)) { G8_MMA(1, 0, At, B0); G8_MMA(1, 1, At, B1); } G8_BAR; G8_SCHED;
            G8_LDB(B0, 1, 0); G8_LDB(B1, 1, 1); G8_SCHED; G8_LDA(At, 1, 0); G8_STAGE(G8_SA(0, 1), a2, o2[1]);
            G8_WAIT_V(8); G8_WAIT_L(0); G8_BAR; G8_MMA(0, 0, At, B0); G8_MMA(0, 1, At, B1); G8_BAR; G8_SCHED;
            if (!HS || !(cur.aux & 256)) { G8_LDA(At, 1, 1); } G8_STAGE(G8_SB(1, 0), b3, voffB); G8_STAGE(G8_SB(1, 1), b3 + hstep, voffB); G8_STAGE(G8_SA(1, 0), a3, o2[0]);
            G8_WAIT_V(8); G8_WAIT_L(0); G8_BAR; if (!HS || !(cur.aux & 256)) { G8_MMA(1, 0, At, B0); G8_MMA(1, 1, At, B1); } G8_BAR; G8_SCHED;
        }
        if (wr == 0) G8_BAR;
        const bool keep = E(acc, cur, wr, wc, fr, fq);
        if (!has_next) break;
        if (!keep)
#pragma unroll
        for (int a = 0; a < 2; ++a)
#pragma unroll
            for (int b = 0; b < 2; ++b)
#pragma unroll
                for (int m = 0; m < 4; ++m)
#pragma unroll
                    for (int n = 0; n < 2; ++n) acc[a][b][m][n] = (f32x4){0.f, 0.f, 0.f, 0.f};
        cur = nxt; ++ui;
        if (wr == 1) G8_BAR;
    }
    G8_WAIT_V(0);
    G8_BAR;
#undef G8_SA
#undef G8_SB
#undef G8_STAGE
#undef G8_LDA
#undef G8_LDB
#undef G8_MMA
#undef G8_WAIT_V
#undef G8_WAIT_L
#undef G8_BAR
#undef G8_SCHED
}
}
struct Args { const float* in[20]; float* out; unsigned char* ws; int ph_lo, ph_hi; };
struct Frame {
    LAS unsigned char* lds;
    volatile LAS unsigned* MISC;
    gu32* ctl;
    int tid, lane, wave, vcu, G;
    int nconv, conv_rank, gemm_rank;
    const Args* a;
};

struct TItem { const float* src; h16* dst; int ldw, ldt; };
__device__ __forceinline__ void p0_item_load(const TItem& t, f32x4 (&v)[8], int lane) {
#pragma unroll
    for (int i = 0; i < 8; ++i) v[i] = __builtin_nontemporal_load((const GAS f32x4*)(t.src + (size_t)(8 * i + (lane >> 3)) * t.ldw + (lane & 7) * 4));
}
__device__ __forceinline__ void p0_item_store(const TItem& t, const f32x4 (&v)[8], LAS float* scr, int lane) {
#pragma unroll
    for (int i = 0; i < 8; ++i) { const int kk = 8 * i + (lane >> 3), n = (lane & 7) * 4;
        scr[(n + 0) * 65 + kk] = v[i].x; scr[(n + 1) * 65 + kk] = v[i].y; scr[(n + 2) * 65 + kk] = v[i].z; scr[(n + 3) * 65 + kk] = v[i].w; }
    LDS_WAIT(); asm volatile("" ::: "memory");
#pragma unroll
    for (int j = 0; j < 4; ++j) { const int n = 8 * j + (lane >> 3), c = lane & 7; const LAS float* s = scr + n * 65 + 8 * c;
        u32x4 o; o.x = pk_h2(s[0], s[1]); o.y = pk_h2(s[2], s[3]); o.z = pk_h2(s[4], s[5]); o.w = pk_h2(s[6], s[7]);
        *(GAS u32x4*)(t.dst + (size_t)n * t.ldt + 8 * c) = o; }
    LDS_WAIT(); asm volatile("" ::: "memory");
}
constexpr int I_IN = (DM / 64) * (NPROJ / 32), I_BSB = (PW / 64) * (DM / 32), I_OUT = (DM / 64) * (DM / 32), I_DENSE = I_IN + I_BSB + I_OUT;
constexpr int I_EG = (DM / 64) * (DE / 32), I_ED = (DE / 64) * (DM / 32), I_E = 2 * I_EG + I_ED, I_EXP = NEXP * I_E;
constexpr int I_EFF = PW * (DM / 64);
constexpr int I_CONV = 22 * I_E;
__device__ __forceinline__ void p0_dense_decode(const Frame& F, int r, TItem& t) {
    const float* W; h16* WT; int ldw, ldt, k0, n0, drow0;
    if (r < I_IN) { const int nblk = NPROJ / 32; W = (F.a->in[6]); ldw = NPROJ; WT = (h16*)((F.a->ws) + WS_WIN); ldt = DM; k0 = 64 * (r / nblk); n0 = 32 * (r % nblk);
        if (n0 < 2048) drow0 = n0; else { const int c = (n0 - 2048) & 1023, isp = n0 >= 3072; drow0 = 2048 + 256 * (c >> 7) + 128 * isp + (c & 127); } }
    else if ((r -= I_IN) < I_BSB) { const int nblk = DM / 32; W = (F.a->in[9]); ldw = DM; WT = (h16*)((F.a->ws) + WS_WCAT); ldt = DM; k0 = 64 * (r / nblk); n0 = 32 * (r % nblk); drow0 = n0; }
    else { r -= I_BSB; const int nblk = DM / 32; W = (F.a->in[11]); ldw = DM; WT = (h16*)((F.a->ws) + WS_WOUT); ldt = DM; k0 = 64 * (r / nblk); n0 = 32 * (r % nblk); drow0 = n0; }
    t.src = W + (size_t)k0 * ldw + n0; t.dst = WT + (size_t)drow0 * ldt + k0; t.ldw = ldw; t.ldt = ldt;
}
__device__ __forceinline__ void p0_expert_decode(const Frame& F, int r, TItem& t) {
    const float* W; h16* WT; int ldw, ldt, k0, n0, drow0;
    const int e = r / I_E; int q = r % I_E;
    if (q < 2 * I_EG) { const int isup = q >= I_EG; q -= isup * I_EG; const int nblk = DE / 32; k0 = 64 * (q / nblk); n0 = 32 * (q % nblk);
        W = (isup ? (F.a->in[17]) : (F.a->in[16])) + (size_t)e * DM * DE; ldw = DE; WT = (h16*)((F.a->ws) + WS_WUP) + (size_t)e * DM * DM; ldt = DM; drow0 = 256 * (n0 >> 7) + 128 * isup + (n0 & 127); }
    else { q -= 2 * I_EG; const int nblk = DM / 32; k0 = 64 * (q / nblk); n0 = 32 * (q % nblk); W = (F.a->in[18]) + (size_t)e * DE * DM; ldw = DM; WT = (h16*)((F.a->ws) + WS_WDN) + (size_t)e * DM * DE; ldt = DE; drow0 = n0; }
    t.src = W + (size_t)k0 * ldw + n0; t.dst = WT + (size_t)drow0 * ldt + k0; t.ldw = ldw; t.ldt = ldt;
}
__device__ __forceinline__ void p0_convert_experts(Frame& F, int cw, int ncw, int i_lo, int i_hi) {
    LAS float* scr = (LAS float*)(F.lds + F.wave * 8320);
    const int rounds = ((i_hi - i_lo + ncw - 1) / ncw + 2) / 3 * 3;
    TItem tA, tB, tC; f32x4 vA[8], vB[8], vC[8];
#define P0_CLAMP(k) ((i_lo + (k) * ncw + cw) < i_hi ? (i_lo + (k) * ncw + cw) : i_hi - 1)
    p0_expert_decode(F, P0_CLAMP(0), tA); p0_item_load(tA, vA, F.lane);
    p0_expert_decode(F, P0_CLAMP(1), tB); p0_item_load(tB, vB, F.lane);
    p0_expert_decode(F, P0_CLAMP(2), tC); p0_item_load(tC, vC, F.lane);
#pragma unroll 1
    for (int k = 3; k < rounds + 3; k += 3) {
        p0_item_store(tA, vA, scr, F.lane); p0_expert_decode(F, P0_CLAMP(k), tA); p0_item_load(tA, vA, F.lane);
        p0_item_store(tB, vB, scr, F.lane); p0_expert_decode(F, P0_CLAMP(k + 1), tB); p0_item_load(tB, vB, F.lane);
        p0_item_store(tC, vC, scr, F.lane); p0_expert_decode(F, P0_CLAMP(k + 2), tC); p0_item_load(tC, vC, F.lane);
    }
#undef P0_CLAMP
}
__device__ __forceinline__ void init_zero(Frame& F) {
    const int per_c = (CTL_ZERO_WORDS + F.G - 1) / F.G, per_m = (NB * NMODS + F.G - 1) / F.G;
    for (int i = F.tid; i < per_c; i += NWAVES * 64) { const int w = F.vcu * per_c + i; if (w < CTL_ZERO_WORDS) __hip_atomic_store((unsigned*)(F.ctl + w), 0u, RLX_AGENT); }
    unsigned* mods = (unsigned*)((F.a->ws) + WS_MODS);
    for (int i = F.tid; i < per_m; i += NWAVES * 64) { const int w = F.vcu * per_m + i; if (w < NB * NMODS) __hip_atomic_store(mods + w, 0u, RLX_AGENT); }
    VM_WAIT();
    __syncthreads();
    if (F.tid == 0) __hip_atomic_store((unsigned*)(F.ctl + CW_FLAGS + F.vcu), INIT_MAGIC, RLX_AGENT);
}
__device__ __forceinline__ void wait_init(Frame& F) {
    if (F.wave == 0) { unsigned sp = 0;
        for (;;) { bool ok = true;
            for (int j = F.lane; j < F.G; j += 64) ok = ok && (__hip_atomic_load((unsigned*)(F.ctl + CW_FLAGS + j), RLX_AGENT) == INIT_MAGIC);
            if (__all(ok)) break;
            __builtin_amdgcn_s_sleep(2); if (++sp > (1u << 20)) break; }
        __builtin_amdgcn_fence(__ATOMIC_ACQUIRE, "agent"); asm volatile("s_waitcnt vmcnt(0)" ::: "memory"); }
    __syncthreads();
}
__device__ __forceinline__ void init_done(Frame& F) { if (F.tid == 0) __hip_atomic_store((unsigned*)(F.ctl + CW_FLAGS + F.vcu), 0u, RLX_AGENT); }
__device__ __forceinline__ void p0_mods(Frame& F) {
    const int jb = F.vcu % (NMODS / 64), kh = F.vcu / (NMODS / 64), j0 = jb * 64, kbase = kh * 512;
    LAS float* cat = (LAS float*)F.lds;
    LAS float* red = (LAS float*)(F.lds + 32768);
    for (int idx = F.tid; idx < NB * 512; idx += NWAVES * 64) { const int b = idx >> 9, k = idx & 511; const float v = (F.a->in[1])[b * DM + kbase + k]; cat[k * 16 + b] = v / (1.f + expf(-v)); }
    __syncthreads();
    float acc[16];
#pragma unroll
    for (int b = 0; b < 16; ++b) acc[b] = 0.f;
    const float* wp = (F.a->in[4]) + (size_t)(kbase + F.wave * 64) * NMODS + j0 + F.lane;
    {   const int kk = 0;
        float wv[64];
#pragma unroll
        for (int u = 0; u < 64; ++u) wv[u] = __builtin_nontemporal_load(wp + (size_t)(kk + u) * NMODS);
#pragma unroll
        for (int u = 0; u < 64; ++u) { const LAS f32x4* cp = (const LAS f32x4*)(cat + (F.wave * 64 + kk + u) * 16);
#pragma unroll
            for (int q = 0; q < 4; ++q) { const f32x4 cv = cp[q]; acc[4 * q] += cv.x * wv[u]; acc[4 * q + 1] += cv.y * wv[u]; acc[4 * q + 2] += cv.z * wv[u]; acc[4 * q + 3] += cv.w * wv[u]; } }
    }
#pragma unroll
    for (int b = 0; b < 16; ++b) red[(F.wave * 16 + b) * 64 + F.lane] = acc[b];
    __syncthreads();
    wait_init(F);
    for (int o = F.tid; o < 16 * 64; o += NWAVES * 64) { const int b = o >> 6, j = o & 63; float s = kh == 0 ? (F.a->in[5])[j0 + j] : 0.f;
#pragma unroll
        for (int w = 0; w < 8; ++w) s += red[(w * 16 + b) * 64 + j];
        atomicAdd((float*)((F.a->ws) + WS_MODS) + b * NMODS + j0 + j, s); }
    VM_WAIT();
    __syncthreads();
    if (F.tid == 0) __hip_atomic_fetch_add((unsigned*)(F.ctl + CW_MODS), 1u, RLX_AGENT);
}
__device__ __forceinline__ void p0_prologue(Frame& F) {
    if (F.vcu < 2 * (NMODS / 64)) p0_mods(F);
    {
        h16* wr = (h16*)((F.a->ws) + WS_WR);
        for (int item = F.vcu * NWAVES + F.wave; item < 1024; item += F.G * NWAVES) { const int n = item >> 4, k = (item & 15) * 64 + F.lane; float v = 0.f;
            if (n < 4) v = (F.a->in[12])[k * 4 + n]; else if (n < 36) v = (F.a->in[14])[((size_t)((n - 4) >> 3) * DM + k) * 8 + ((n - 4) & 7)];
            wr[n * DM + k] = (h16)v; }
    }
    LAS float* scr = (LAS float*)(F.lds + F.wave * 8320);
    const int gw = F.vcu * NWAVES + F.wave;
    const int NGW = F.G * NWAVES, B1 = NGW / 2;
    for (int it = gw; it < I_DENSE; it += NGW) { TItem t; f32x4 v[8]; p0_dense_decode(F, it, t); p0_item_load(t, v, F.lane); p0_item_store(t, v, scr, F.lane); }
    p0_convert_experts(F, gw, NGW, F.nconv ? I_CONV : 0, I_EXP);
    h16* WBEFF = (h16*)((F.a->ws) + WS_WCAT) + PW;
    for (int r = gw - B1; r >= 0 && r < (PW / 8) * (DM / 64); r += NGW) {
        const int r8 = r / (DM / 64), nb = r % (DM / 64), g = r8 >> 4; const float* pw = (F.a->in[7]) + (size_t)(r8 * 8) * 128; const float* ps = (F.a->in[8]) + g * 128;
        const float* wb = (F.a->in[10]) + (size_t)(g * 128) * DM + nb * 64 + F.lane; float acc[8];
#pragma unroll
        for (int c = 0; c < 8; ++c) acc[c] = 0.f;
#pragma unroll 1
        for (int d0 = 0; d0 < 128; d0 += 64) { float wv[64];
#pragma unroll
            for (int d = 0; d < 64; ++d) wv[d] = wb[(size_t)(d0 + d) * DM];
#pragma unroll
            for (int d = 0; d < 64; ++d) wv[d] *= ps[d0 + d];
#pragma unroll
            for (int d = 0; d < 64; ++d)
#pragma unroll
                for (int c = 0; c < 8; ++c) acc[c] += pw[c * 128 + d0 + d] * wv[d]; }
        u32x4 o; o.x = pk_h2(acc[0], acc[1]); o.y = pk_h2(acc[2], acc[3]); o.z = pk_h2(acc[4], acc[5]); o.w = pk_h2(acc[6], acc[7]);
        *(GAS u32x4*)(WBEFF + (size_t)(nb * 64 + F.lane) * DM + r8 * 8) = o;
    }
}
__device__ __forceinline__ void rownorm_mod_row(const float* xr, const float* g, const float* mb, int shift_off, int scale_off, h16* orow, int lane) {
    f32x4 v[4]; float ss = 0.f;
#pragma unroll
    for (int j = 0; j < 4; ++j) { v[j] = *(const GAS f32x4*)(xr + j * 256 + lane * 4); ss += (v[j].x * v[j].x + v[j].y * v[j].y) + (v[j].z * v[j].z + v[j].w * v[j].w); }
    ss = wave_sum(ss);
    const float rs = 1.0f / sqrtf(ss * (1.0f / DM) + EPS);
#pragma unroll
    for (int j = 0; j < 4; ++j) { const int idx = j * 256 + lane * 4;
        const f32x4 gg = *(const GAS f32x4*)(g + idx), sc = *(const GAS f32x4*)(mb + scale_off + idx), sh = *(const GAS f32x4*)(mb + shift_off + idx);
        u32x2 o; o.x = pk_h2(v[j].x * rs * gg.x * (1.f + sc.x) + sh.x, v[j].y * rs * gg.y * (1.f + sc.y) + sh.y);
        o.y = pk_h2(v[j].z * rs * gg.z * (1.f + sc.z) + sh.z, v[j].w * rs * gg.w * (1.f + sc.w) + sh.w);
        *(GAS u32x2*)(orow + idx) = o; }
}
__device__ __forceinline__ void wait_mods(Frame& F) {
    if (F.tid == 0) { unsigned sp = 0; const unsigned want = 2u * (NMODS / 64);
        while (__hip_atomic_load((unsigned*)(F.ctl + CW_MODS), RLX_AGENT) < want) { __builtin_amdgcn_s_sleep(2); if (++sp > (1u << 20)) { __hip_atomic_store((unsigned*)(F.ctl + CW_TMO), 1u, RLX_AGENT); break; } }
        __builtin_amdgcn_fence(__ATOMIC_ACQUIRE, "agent"); asm volatile("s_waitcnt vmcnt(0)" ::: "memory"); }
    __syncthreads();
}
__device__ __forceinline__ void p1a_rows(Frame& F) {
    const int gw = F.vcu * NWAVES + F.wave, NGW = F.G * NWAVES; const float* mods = (const float*)((F.a->ws) + WS_MODS); h16* Hh = (h16*)((F.a->ws) + WS_RA);
    for (int m0 = gw * 16; m0 < M; m0 += NGW * 16) {
        const float* mb = mods + (m0 / SEQ) * NMODS; f32x4 ca[4], cb[4];
#pragma unroll
        for (int j = 0; j < 4; ++j) { const int idx = j * 256 + F.lane * 4; const f32x4 gg = *(const GAS f32x4*)((F.a->in[2]) + idx), sc = *(const GAS f32x4*)(mb + 1024 + idx); cb[j] = *(const GAS f32x4*)(mb + idx); ca[j] = gg * (sc + 1.f); }
#pragma unroll 1
        for (int r8 = 0; r8 < 16; r8 += 8) {
            f32x4 v[8][4];
#pragma unroll
            for (int rr = 0; rr < 8; ++rr)
#pragma unroll
                for (int j = 0; j < 4; ++j) v[rr][j] = __builtin_nontemporal_load((const GAS f32x4*)((F.a->in[0]) + (size_t)(m0 + r8 + rr) * DM + j * 256 + F.lane * 4));
#pragma unroll
            for (int rr = 0; rr < 8; ++rr) { float ss = 0.f;
#pragma unroll
                for (int j = 0; j < 4; ++j) ss += (v[rr][j].x * v[rr][j].x + v[rr][j].y * v[rr][j].y) + (v[rr][j].z * v[rr][j].z + v[rr][j].w * v[rr][j].w);
                ss = wave_sum(ss);
                const float rs = 1.0f / sqrtf(ss * (1.0f / DM) + EPS);
#pragma unroll
                for (int j = 0; j < 4; ++j) { const f32x4 h = v[rr][j] * rs * ca[j] + cb[j]; u32x2 o; o.x = pk_h2(h.x, h.y); o.y = pk_h2(h.z, h.w);
                    *(GAS u32x2*)(Hh + (size_t)(m0 + r8 + rr) * DM + j * 256 + F.lane * 4) = o; } }
        }
    }
}

template <int parts> struct DenseSchedT {
    static constexpr bool GATHER = false, HALFABLE = false;
    int nM, nN, nwg, G, c, K, LD; const char* Bt; const char* A;
    __device__ __forceinline__ void init(int M_, int N_, int K_, int LD_, int, const void* A_, const void* Bt_, int G_, int c_) { nM = M_ / 256; nN = N_ / 256; nwg = nM * nN; G = G_; c = c_; K = K_; LD = LD_; A = (const char*)A_; Bt = (const char*)Bt_; }
    __device__ __forceinline__ bool next(int i, g8::Unit& u) const {
        const int part = i % parts; const long L = (long)(i / parts) * G + c; if (L >= nwg) return false;
        int wgid = (int)L; { const int q = nwg / 8, r = nwg % 8, xcd = wgid % 8, off = wgid / 8; wgid = (xcd < r ? xcd * (q + 1) : r * (q + 1) + (xcd - r) * q) + off; }
        const int nig = 8 * nN, gid = wgid / nig, fm = gid * 8, gsz = (nM - fm) < 8 ? (nM - fm) : 8;
        const int pm = fm + ((wgid % nig) % gsz), pn = (wgid % nig) / gsz;
        u.aoff[0][0] = 0u; u.aoff[0][1] = 0u; u.aoff[1][0] = 0u; u.aoff[1][1] = 0u;
        u.pn = pn; u.orow = pm * 256; u.aux = part; u.Bb = Bt + ((size_t)pn * 256 * LD + (size_t)part * K) * 2; u.Ab = A + ((size_t)pm * 256 * LD + (size_t)part * K) * 2;
        return true;
    }
};
typedef DenseSchedT<1> DenseSched;
struct EpiInProj {
    static constexpr bool PERM = true, STORE_ONLY = true;
    h16 *Q, *K, *V, *P, *RB, *SPB;
    __device__ __forceinline__ bool operator()(g8::f32x4 (&acc)[2][2][4][2], const g8::Unit& u, int wr, int wc, int fr, int fq) const {
        const int pn = u.pn; const int row0 = u.orow + wr * 64 + fr;
        if (pn >= 8) {
            const int col0 = (pn - 8) * 128 + wc * 32 + 8 * fq;
#pragma unroll
            for (int ai = 0; ai < 2; ++ai)
#pragma unroll
                for (int m = 0; m < 4; ++m) { const size_t off = (size_t)(row0 + ai * 128 + m * 16) * DM + col0; float rr[8], sp[8];
#pragma unroll
                    for (int n = 0; n < 2; ++n)
#pragma unroll
                        for (int j = 0; j < 4; ++j) { const float es = __builtin_amdgcn_exp2f(-acc[ai][0][m][n][j] * L2E), ep = __builtin_amdgcn_exp2f(-acc[ai][1][m][n][j] * L2E);
                            const float ip = 1.f + ep; sp[4 * n + j] = __builtin_amdgcn_rcpf(ip); rr[4 * n + j] = __builtin_fminf(ip * __builtin_amdgcn_rcpf(1.f + es), 60000.f); }
                    u32x4 w; w.x = pk_h2(rr[0], rr[1]); w.y = pk_h2(rr[2], rr[3]); w.z = pk_h2(rr[4], rr[5]); w.w = pk_h2(rr[6], rr[7]);
                    *(GAS u32x4*)(RB + off) = w;
                    w.x = pk_h2(sp[0], sp[1]); w.y = pk_h2(sp[2], sp[3]); w.z = pk_h2(sp[4], sp[5]); w.w = pk_h2(sp[6], sp[7]);
                    *(GAS u32x4*)(SPB + off) = w; }
            return false;
        }
        const int t = pn >> 1; h16* base = t == 0 ? Q : t == 1 ? K : t == 2 ? V : P; const float sc = t == 0 ? C2 : 1.f;
        const int col0 = (pn & 1) * 256 + wc * 32 + 8 * fq;
        const bool headmajor = pn < 6;
#pragma unroll
        for (int ai = 0; ai < 2; ++ai)
#pragma unroll
            for (int m = 0; m < 4; ++m) { const int row = row0 + ai * 128 + m * 16;
                h16* rowp = headmajor ? base + ((size_t)((row / SEQ) * NH) * SEQ + (row % SEQ)) * HD + (size_t)(col0 >> 6) * SEQ * HD + (col0 & 63) : base + (size_t)row * PW + col0;
                const int bjstep = headmajor ? 2 * SEQ * HD : 128;
#pragma unroll
                for (int bj = 0; bj < 2; ++bj) { const g8::f32x4 v0 = acc[ai][bj][m][0] * sc, v1 = acc[ai][bj][m][1] * sc;
                    u32x4 w; w.x = pk_h2(v0[0], v0[1]); w.y = pk_h2(v0[2], v0[3]); w.z = pk_h2(v1[0], v1[1]); w.w = pk_h2(v1[2], v1[3]);
                    *(GAS u32x4*)(rowp + bj * bjstep) = w; } }
        return false;
    }
};
namespace att {
typedef short v4i16 __attribute__((ext_vector_type(4)));
__device__ __forceinline__ int crow(int r, int hi) { return (r & 3) + 8 * (r >> 2) + 4 * hi; }
__device__ __forceinline__ void swap32(float a, float b, float& r0, float& r1) {
    auto rr = __builtin_amdgcn_permlane32_swap(__float_as_uint(a), __float_as_uint(b), false, false);
    r0 = __uint_as_float(rr[0]); r1 = __uint_as_float(rr[1]);
}
template <bool DIAG>
__device__ __forceinline__ void tile_math(const f32x16& p, float& L, int r32, int hi, float hf, f16x8& pa0, f16x8& pa1) {
    float ls[16], yc[16];
#pragma unroll
    for (int r = 0; r < 16; ++r) {
        yc[r] = __builtin_amdgcn_fmed3f(p[r], -1.0e30f, 100.f);
        ls[r] = -__builtin_amdgcn_logf(1.f + __builtin_amdgcn_exp2f(yc[r]));
        if (DIAG) { if (!(crow(r, hi) < r32)) ls[r] = 0.f; }
    }
    float G[4];
#pragma unroll
    for (int g = 0; g < 4; ++g) G[g] = (ls[4 * g] + ls[4 * g + 1]) + (ls[4 * g + 2] + ls[4 * g + 3]);
    float os[4]; os[3] = 0.f; os[2] = G[3]; os[1] = G[3] + G[2]; os[0] = os[1] + G[1];
    float base[4];
#pragma unroll
    for (int g = 0; g < 4; ++g) { float r0, r1; swap32(os[g] + hf * G[g], os[g], r0, r1); base[g] = L + (r0 + r1); }
    float tot; { const float t = os[0] + G[0]; float r0, r1; swap32(t, t, r0, r1); tot = r0 + r1; }
    float a[16];
#pragma unroll
    for (int g = 0; g < 4; ++g) {
        float ex = base[g];
#pragma unroll
        for (int q = 3; q >= 0; --q) { const int r = 4 * g + q; ex += ls[r]; float v = __builtin_amdgcn_exp2f(yc[r] + ex); if (DIAG) { if (!(crow(r, hi) < r32)) v = 0.f; } a[r] = v; }
    }
    L += tot;
#pragma unroll
    for (int j = 0; j < 8; ++j) { pa0[j] = (_Float16)a[j]; pa1[j] = (_Float16)a[8 + j]; }
}
__device__ __forceinline__ f16x8 vtr2(const LAS unsigned char* p) {
    const v4i16 lo = __builtin_amdgcn_ds_read_tr16_b64_v4i16((LAS v4i16*)p);
    const v4i16 hi = __builtin_amdgcn_ds_read_tr16_b64_v4i16((LAS v4i16*)(p + 512));
    typedef short v8i16 __attribute__((ext_vector_type(8)));
    const v8i16 w = {lo[0], lo[1], lo[2], lo[3], hi[0], hi[1], hi[2], hi[3]};
    return __builtin_bit_cast(f16x8, w);
}
template <bool DIAG>
__device__ __forceinline__ bool attn_tile_lds(const LAS unsigned char* ks, const LAS unsigned char* vs, const f16x8 (&qf)[4], f32x16& o0, f32x16& o1, float& L, int ta, int r32, int hi, float hf) {
    f16x8 kf[4];
#pragma unroll
    for (int s = 0; s < 4; ++s) kf[s] = *(const LAS f16x8*)(ks + r32 * 128 + (((2 * s + hi) ^ (r32 & 7)) * 16));
    f32x16 p = {};
#pragma unroll
    for (int s = 0; s < 4; ++s) p = __builtin_amdgcn_mfma_f32_32x32x16_f16(kf[s], qf[s], p, 0, 0, 0);
    f16x8 pa0, pa1;
    tile_math<DIAG>(p, L, r32, hi, hf, pa0, pa1);
    const f16x8 v00 = vtr2(vs + ta), v01 = vtr2(vs + ta + 1024), v10 = vtr2(vs + ta + 2048), v11 = vtr2(vs + ta + 3072);
    o0 = __builtin_amdgcn_mfma_f32_32x32x16_f16(v00, pa0, o0, 0, 0, 0);
    o0 = __builtin_amdgcn_mfma_f32_32x32x16_f16(v01, pa1, o0, 0, 0, 0);
    o1 = __builtin_amdgcn_mfma_f32_32x32x16_f16(v10, pa0, o1, 0, 0, 0);
    o1 = __builtin_amdgcn_mfma_f32_32x32x16_f16(v11, pa1, o1, 0, 0, 0);
    return __all(L < EXIT_L2);
}
constexpr int ATT_WIN = 14, ATT_HIST = ATT_WIN - 8;
constexpr int ATT_KOFF = 0, ATT_VOFF = ATT_WIN * 4096, ATT_PRIV = 2 * ATT_WIN * 4096;
}
__device__ __forceinline__ void p2_attention_lds(Frame& F, h16* O) {
    using namespace att;
    const h16* Q = (const h16*)((F.a->ws) + WS_Q); const h16* K = (const h16*)((F.a->ws) + WS_K); const h16* V = (const h16*)((F.a->ws) + WS_V);
    const int lane = F.lane, r32 = lane & 31, hi = lane >> 5; const float hf = (float)hi;
    const int ta = (4 * hi + ((lane & 15) >> 2)) * 64 + ((lane >> 4) & 1) * 32 + (lane & 3) * 8;
    const int wa = ((lane & 7) >> 2) * 2048 + (lane >> 3) * 64 + (lane & 3) * 16;
    LAS unsigned char* priv = F.lds + ATT_PRIV + F.wave * 4096;
    const int t2 = F.tid & 255, skey = t2 >> 3, sc = t2 & 7; const bool isk = F.tid >= 256;
    const int sdst = isk ? ATT_KOFF + skey * 128 + ((sc ^ (skey & 7)) * 16) : ATT_VOFF + (sc >> 2) * 2048 + (skey >> 4) * 1024 + (skey & 15) * 64 + (sc & 3) * 16;
    u32x4 sv[ATT_WIN]; f16x8 qn[4];
#define ATT_STAGE_LOAD(R_) do { const int bh_ = (R_) >> 3, qb0_ = ((R_) & 7) * 8; const size_t hb_ = (size_t)bh_ * SEQ * HD; \
        const int jlo_ = qb0_ - ATT_HIST > 0 ? qb0_ - ATT_HIST : 0, ntile_ = qb0_ + 8 - jlo_; \
        const h16* src_ = (isk ? K : V) + hb_ + (size_t)(32 * jlo_ + skey) * HD + sc * 8; \
        _Pragma("unroll") for (int t = 0; t < ATT_WIN; ++t) { const int tt = t < ntile_ ? t : ntile_ - 1; sv[t] = *(const GAS u32x4*)(src_ + (size_t)tt * 32 * HD); } \
        const h16* qp_ = Q + hb_ + (size_t)((qb0_ + F.wave) * 32 + r32) * HD + hi * 8; \
        _Pragma("unroll") for (int s = 0; s < 4; ++s) qn[s] = *(const GAS f16x8*)(qp_ + 16 * s); } while (0)
    const int NR = NB * NH * 8;
    if (F.vcu * 4 < NR) ATT_STAGE_LOAD(F.vcu * 4);
    for (int rd = F.vcu * 4; rd < NR; rd += F.G * 4)
    for (int rr = 0; rr < 4; ++rr) {
        const int R = rd + rr, bh = R >> 3, qb0 = (R & 7) * 8, b = bh >> 3, hh = bh & 7;
        const size_t hb = (size_t)bh * SEQ * HD; const size_t rowb = (size_t)b * SEQ;
        const int jlo = qb0 - ATT_HIST > 0 ? qb0 - ATT_HIST : 0;
        __syncthreads();
#pragma unroll
        for (int t = 0; t < ATT_WIN; ++t) *(LAS u32x4*)(F.lds + sdst + t * 4096) = sv[t];
        f16x8 qf[4];
#pragma unroll
        for (int s = 0; s < 4; ++s) qf[s] = qn[s];
        __syncthreads();
        { const int Rn = (rr < 3) ? R + 1 : rd + F.G * 4; const int Rc = Rn < NR ? Rn : R; ATT_STAGE_LOAD(Rc); }
        const int qb = qb0 + F.wave;

        f32x16 o0 = {}, o1 = {}; float L = 0.f;
        int j = qb;
        bool done = attn_tile_lds<true>(F.lds + ATT_KOFF + (j - jlo) * 4096, F.lds + ATT_VOFF + (j - jlo) * 4096, qf, o0, o1, L, ta, r32, hi, hf) || j == 0;
        --j;
        while (!done && j >= jlo) { done = attn_tile_lds<false>(F.lds + ATT_KOFF + (j - jlo) * 4096, F.lds + ATT_VOFF + (j - jlo) * 4096, qf, o0, o1, L, ta, r32, hi, hf) || j == 0; --j; }
        while (!done) {
            const h16* kp = K + hb + (size_t)(32 * j + r32) * HD + hi * 8; const h16* vp = V + hb + (size_t)(32 * j + (lane >> 3)) * HD + (lane & 7) * 8;
            f16x8 kf[4]; u32x4 vr[4];
#pragma unroll
            for (int s = 0; s < 4; ++s) kf[s] = *(const GAS f16x8*)(kp + 16 * s);
#pragma unroll
            for (int i = 0; i < 4; ++i) vr[i] = *(const GAS u32x4*)(vp + (size_t)(8 * i) * HD);
#pragma unroll
            for (int i = 0; i < 4; ++i) *(LAS u32x4*)(priv + wa + (i >> 1) * 1024 + (i & 1) * 512) = vr[i];
            f32x16 p = {};
#pragma unroll
            for (int s = 0; s < 4; ++s) p = __builtin_amdgcn_mfma_f32_32x32x16_f16(kf[s], qf[s], p, 0, 0, 0);
            f16x8 pa0, pa1;
            tile_math<false>(p, L, r32, hi, hf, pa0, pa1);
            asm volatile("" ::: "memory");
            const f16x8 v00 = vtr2(priv + ta), v01 = vtr2(priv + ta + 1024), v10 = vtr2(priv + ta + 2048), v11 = vtr2(priv + ta + 3072);
            o0 = __builtin_amdgcn_mfma_f32_32x32x16_f16(v00, pa0, o0, 0, 0, 0);
            o0 = __builtin_amdgcn_mfma_f32_32x32x16_f16(v01, pa1, o0, 0, 0, 0);
            o1 = __builtin_amdgcn_mfma_f32_32x32x16_f16(v10, pa0, o1, 0, 0, 0);
            o1 = __builtin_amdgcn_mfma_f32_32x32x16_f16(v11, pa1, o1, 0, 0, 0);
            asm volatile("" ::: "memory");
            done = __all(L < EXIT_L2) || j == 0; --j;
        }
        h16* op = O + (rowb + qb * 32 + r32) * DM + hh * HD + 4 * hi;
#pragma unroll
        for (int g = 0; g < 4; ++g) {
            u32x2 w0, w1; w0.x = pk_h2(o0[4 * g], o0[4 * g + 1]); w0.y = pk_h2(o0[4 * g + 2], o0[4 * g + 3]); w1.x = pk_h2(o1[4 * g], o1[4 * g + 1]); w1.y = pk_h2(o1[4 * g + 2], o1[4 * g + 3]);
            *(GAS u32x2*)(op + 8 * g) = w0; *(GAS u32x2*)(op + 32 + 8 * g) = w1;
        }
    }
#undef ATT_STAGE_LOAD
    __syncthreads();
}
template <int W> __device__ __forceinline__ void pool_win_load(const h16* P, int row_first, int ch, u32x4 (&x)[W + 3]) {
    const int t_first = row_first & (SEQ - 1);
#pragma unroll
    for (int i = 0; i < W + 3; ++i) { const int back = (W - 1) - i;
        const int bk = back <= t_first ? back : t_first;
        x[i] = *(const GAS u32x4*)(P + (size_t)(row_first - bk) * PW + ch * 8); }
}
template <int W> __device__ __forceinline__ void pool_win_store(h16* PO, int row_first, int ch, u32x4 (&x)[W + 3]) {
    const int t_first = row_first & (SEQ - 1);
    float s[8];
#pragma unroll
    for (int e = 0; e < 8; ++e) s[e] = 0.f;
#pragma unroll
    for (int i = 0; i < W + 3; ++i) { const int back = (W - 1) - i; if (back > t_first) x[i] = (u32x4){0u, 0u, 0u, 0u}; }
#pragma unroll
    for (int i = 0; i < W; ++i) { const f16x8 v = __builtin_bit_cast(f16x8, x[i]);
#pragma unroll
        for (int e = 0; e < 8; ++e) s[e] += (float)v[e]; }
#pragma unroll
    for (int j = 0; j < 4; ++j) {
        const f16x8 cur = __builtin_bit_cast(f16x8, x[W - 1 + j]);
        if (j > 0) { const f16x8 drop = __builtin_bit_cast(f16x8, x[j - 1]);
#pragma unroll
            for (int e = 0; e < 8; ++e) s[e] += (float)cur[e] - (float)drop[e]; }
        const int t = t_first + j; const float inv = 1.f / (float)((t + 1) < W ? (t + 1) : W);
        u32x4 o; o.x = pk_h2(s[0] * inv - (float)cur[0], s[1] * inv - (float)cur[1]); o.y = pk_h2(s[2] * inv - (float)cur[2], s[3] * inv - (float)cur[3]);
        o.z = pk_h2(s[4] * inv - (float)cur[4], s[5] * inv - (float)cur[5]); o.w = pk_h2(s[6] * inv - (float)cur[6], s[7] * inv - (float)cur[7]);
        *(GAS u32x4*)(PO + (size_t)(row_first + j) * DM + PW + ch * 8) = o;
    }
}
__device__ __forceinline__ void p2_pool(Frame& F) {
    const h16* P = (const h16*)((F.a->ws) + WS_P); h16* PO = (h16*)((F.a->ws) + WS_CAT);
    const int gw = F.vcu * NWAVES + F.wave, NGW = F.G * NWAVES;
    for (int it = gw; it < M / 16; it += NGW) {
        const int row_first = it * 16 + 4 * (F.lane >> 4), c16 = F.lane & 15;
        { u32x4 x3[19]; pool_win_load<16>(P, row_first, 48 + c16, x3); pool_win_store<16>(PO, row_first, 48 + c16, x3); }
        { u32x4 x0[5], x1[7], x2[11];
          pool_win_load<2>(P, row_first, c16, x0); pool_win_load<4>(P, row_first, 16 + c16, x1); pool_win_load<8>(P, row_first, 32 + c16, x2);
          pool_win_store<2>(PO, row_first, c16, x0); pool_win_store<4>(PO, row_first, 16 + c16, x1); pool_win_store<8>(PO, row_first, 32 + c16, x2); }
    }
}
struct EpiBranchFused {
    static constexpr bool PERM = true, STORE_ONLY = false;
    h16* MG; const h16* RB; const h16* SPB;
    __device__ __forceinline__ bool operator()(g8::f32x4 (&acc)[2][2][4][2], const g8::Unit& u, int wr, int wc, int fr, int fq) const {
        const int row0 = u.orow + wr * 64 + fr, col0 = u.pn * 256 + wc * 32 + 8 * fq;
        if (u.aux == 0) {
            f16x8 rv[2][4][2];
#pragma unroll
            for (int ai = 0; ai < 2; ++ai)
#pragma unroll
                for (int m = 0; m < 4; ++m)
#pragma unroll
                    for (int bj = 0; bj < 2; ++bj) rv[ai][m][bj] = *(const GAS f16x8*)(RB + (size_t)(row0 + ai * 128 + m * 16) * DM + col0 + bj * 128);
#pragma unroll
            for (int ai = 0; ai < 2; ++ai)
#pragma unroll
                for (int m = 0; m < 4; ++m)
#pragma unroll
                    for (int bj = 0; bj < 2; ++bj)
#pragma unroll
                        for (int j = 0; j < 4; ++j) { acc[ai][bj][m][0][j] *= (float)rv[ai][m][bj][j]; acc[ai][bj][m][1][j] *= (float)rv[ai][m][bj][4 + j]; }
            return true;
        }
        f16x8 sgv[2][4][2];
#pragma unroll
        for (int ai = 0; ai < 2; ++ai)
#pragma unroll
            for (int m = 0; m < 4; ++m)
#pragma unroll
                for (int bj = 0; bj < 2; ++bj) sgv[ai][m][bj] = *(const GAS f16x8*)(SPB + (size_t)(row0 + ai * 128 + m * 16) * DM + col0 + bj * 128);
#pragma unroll
        for (int ai = 0; ai < 2; ++ai)
#pragma unroll
            for (int m = 0; m < 4; ++m) { const size_t off = (size_t)(row0 + ai * 128 + m * 16) * DM + col0;
#pragma unroll
                for (int bj = 0; bj < 2; ++bj) { const g8::f32x4 v0 = acc[ai][bj][m][0], v1 = acc[ai][bj][m][1];
                    const f16x8 sg = sgv[ai][m][bj];
                    u32x4 w; w.x = pk_h2((float)sg[0] * v0[0], (float)sg[1] * v0[1]); w.y = pk_h2((float)sg[2] * v0[2], (float)sg[3] * v0[3]);
                    w.z = pk_h2((float)sg[4] * v1[0], (float)sg[5] * v1[1]); w.w = pk_h2((float)sg[6] * v1[2], (float)sg[7] * v1[3]);
                    *(GAS u32x4*)(MG + off + bj * 128) = w; } }
        return false;
    }
};
struct EpiOutProj {
    static constexpr bool PERM = true, STORE_ONLY = false;
    const float* x; const float* mods; h16* x1;
    __device__ __forceinline__ bool operator()(g8::f32x4 (&acc)[2][2][4][2], const g8::Unit& u, int wr, int wc, int fr, int fq) const {
        const int row0 = u.orow + wr * 64 + fr, col0 = u.pn * 256 + wc * 32 + 8 * fq; const float* gt = mods + (u.orow / SEQ) * NMODS + 2048;
        g8::f32x4 gv[2][2];
#pragma unroll
        for (int bj = 0; bj < 2; ++bj)
#pragma unroll
            for (int n = 0; n < 2; ++n) gv[bj][n] = *(const GAS g8::f32x4*)(gt + col0 + bj * 128 + n * 4);
#pragma unroll
        for (int ai = 0; ai < 2; ++ai) {
            g8::f32x4 xv[4][2][2];
#pragma unroll
            for (int m = 0; m < 4; ++m)
#pragma unroll
                for (int bj = 0; bj < 2; ++bj)
#pragma unroll
                    for (int n = 0; n < 2; ++n) xv[m][bj][n] = __builtin_nontemporal_load((const GAS g8::f32x4*)(x + (size_t)(row0 + ai * 128 + m * 16) * DM + col0 + bj * 128 + n * 4));
#pragma unroll
            for (int m = 0; m < 4; ++m) { const size_t off = (size_t)(row0 + ai * 128 + m * 16) * DM + col0;
#pragma unroll
                for (int bj = 0; bj < 2; ++bj) {
                    const g8::f32x4 r0 = xv[m][bj][0] + gv[bj][0] * acc[ai][bj][m][0], r1 = xv[m][bj][1] + gv[bj][1] * acc[ai][bj][m][1];
                    u32x4 w; w.x = pk_h2(r0[0], r0[1]); w.y = pk_h2(r0[2], r0[3]); w.z = pk_h2(r1[0], r1[1]); w.w = pk_h2(r1[2], r1[3]);
                    *(GAS u32x4*)(x1 + off + bj * 128) = w; } }
            asm volatile("" ::: "memory");
        }
        return false;
    }
};
constexpr int MISC_LCNT = 16, MISC_GBASE = 48;
constexpr int RT_WR_OFF = 32768, RT_WR_PITCH = 2064;
__device__ __forceinline__ void p5_route(Frame& F) {
    const float* mods = (const float*)((F.a->ws) + WS_MODS); h16* H2 = (h16*)((F.a->ws) + WS_RA); const h16* WR = (const h16*)((F.a->ws) + WS_WR);
    int* eid = (int*)((F.a->ws) + WS_EID); float* cw = (float*)((F.a->ws) + WS_CW); int* pos = (int*)((F.a->ws) + WS_POS); int* list = (int*)((F.a->ws) + WS_LIST);
    int* lcnt = (int*)(F.lds + MISC_OFF) + MISC_LCNT; int* gbase = (int*)(F.lds + MISC_OFF) + MISC_GBASE;
    float* lgs = (float*)(F.lds + F.wave * 4096);
    const int fr = F.lane & 15, fq = F.lane >> 4;
    {
        u32x4 wv[12];
#pragma unroll
        for (int i = 0; i < 12; ++i) { const int p = F.tid + i * 512; wv[i] = *(const GAS u32x4*)(WR + (size_t)(p >> 7) * DM + (p & 127) * 8); }
#pragma unroll
        for (int i = 0; i < 12; ++i) { const int p = F.tid + i * 512; *(LAS u32x4*)(F.lds + RT_WR_OFF + (p >> 7) * RT_WR_PITCH + (p & 127) * 16) = wv[i]; }
    }
    for (int chunk = F.vcu; chunk < M / 128; chunk += F.G) {
        const int row0 = chunk * 128 + F.wave * 16;
        if (F.tid < 32) lcnt[F.tid] = 0;
        __syncthreads();
        {
            const float* mb = mods + (row0 / SEQ) * NMODS; float ca[16], cb[16];
#pragma unroll
            for (int h = 0; h < 2; ++h)
#pragma unroll
                for (int q = 0; q < 2; ++q) { const int idx = h * 512 + F.lane * 8 + q * 4;
                    const f32x4 gg = *(const GAS f32x4*)((F.a->in[3]) + idx), sc = *(const GAS f32x4*)(mb + 4096 + idx), sh = *(const GAS f32x4*)(mb + 3072 + idx);
#pragma unroll
                    for (int j = 0; j < 4; ++j) { ca[h * 8 + q * 4 + j] = gg[j] * (1.f + sc[j]); cb[h * 8 + q * 4 + j] = sh[j]; } }
            const h16* X1 = (const h16*)((F.a->ws) + WS_X1);
            f16x8 xv[16][2];
#pragma unroll
            for (int rr = 0; rr < 16; ++rr)
#pragma unroll
                for (int h = 0; h < 2; ++h) xv[rr][h] = *(const GAS f16x8*)(X1 + (size_t)(row0 + rr) * DM + h * 512 + F.lane * 8);
#pragma unroll
            for (int rr = 0; rr < 16; ++rr) {
                float xf[16]; float ss = 0.f;
#pragma unroll
                for (int j = 0; j < 16; ++j) { xf[j] = (float)xv[rr][j >> 3][j & 7]; ss += xf[j] * xf[j]; }
                ss = wave_sum(ss);
                const float rs = 1.0f / sqrtf(ss * (1.0f / DM) + EPS);
#pragma unroll
                for (int h = 0; h < 2; ++h) { u32x4 o;
                    o.x = pk_h2(xf[8 * h] * rs * ca[8 * h] + cb[8 * h], xf[8 * h + 1] * rs * ca[8 * h + 1] + cb[8 * h + 1]); o.y = pk_h2(xf[8 * h + 2] * rs * ca[8 * h + 2] + cb[8 * h + 2], xf[8 * h + 3] * rs * ca[8 * h + 3] + cb[8 * h + 3]);
                    o.z = pk_h2(xf[8 * h + 4] * rs * ca[8 * h + 4] + cb[8 * h + 4], xf[8 * h + 5] * rs * ca[8 * h + 5] + cb[8 * h + 5]); o.w = pk_h2(xf[8 * h + 6] * rs * ca[8 * h + 6] + cb[8 * h + 6], xf[8 * h + 7] * rs * ca[8 * h + 7] + cb[8 * h + 7]);
                    *(GAS u32x4*)(H2 + (size_t)(row0 + rr) * DM + h * 512 + F.lane * 8) = o; }
            }
        }
        VM_WAIT();
        g8::f32x4 acc[3];
#pragma unroll
        for (int nf = 0; nf < 3; ++nf) acc[nf] = (g8::f32x4){0.f, 0.f, 0.f, 0.f};
        {
            const h16* ap = H2 + (size_t)(row0 + fr) * DM + fq * 8; const LAS unsigned char* bp = F.lds + RT_WR_OFF + fr * RT_WR_PITCH + fq * 16;
            f16x8 av[32];
#pragma unroll
            for (int kb = 0; kb < 32; ++kb) av[kb] = *(const GAS f16x8*)(ap + 32 * kb);
#pragma unroll
            for (int kb = 0; kb < 32; ++kb)
#pragma unroll
                for (int nf = 0; nf < 3; ++nf) { const f16x8 bf = *(const LAS f16x8*)(bp + (16 * nf) * RT_WR_PITCH + 64 * kb); acc[nf] = __builtin_amdgcn_mfma_f32_16x16x32_f16(av[kb], bf, acc[nf], 0, 0, 0); }
        }
#pragma unroll
        for (int nf = 0; nf < 3; ++nf)
#pragma unroll
            for (int rg = 0; rg < 4; ++rg) lgs[(4 * fq + rg) * 49 + 16 * nf + fr] = acc[nf][rg];
        LDS_WAIT(); asm volatile("" ::: "memory");
        const float* lr = lgs + fr * 49;
        float gl[4];
#pragma unroll
        for (int j = 0; j < 4; ++j) gl[j] = lr[j] + (F.a->in[13])[j];
        int gsel = 0; float gm = gl[0];
#pragma unroll
        for (int j = 1; j < 4; ++j) if (gl[j] > gm) { gm = gl[j]; gsel = j; }
        float den = 0.f;
#pragma unroll
        for (int j = 0; j < 4; ++j) den += expf(gl[j] - gm);
        const float pg = 1.f / den;
        float el[8];
#pragma unroll
        for (int e = 0; e < 8; ++e) el[e] = lr[4 + gsel * 8 + e] + (F.a->in[15])[gsel * 8 + e];
        int i0 = 0; float v0 = el[0];
#pragma unroll
        for (int e = 1; e < 8; ++e) if (el[e] > v0) { v0 = el[e]; i0 = e; }
        int i1 = 0; float v1 = -3.0e38f;
#pragma unroll
        for (int e = 0; e < 8; ++e) if (e != i0 && el[e] > v1) { v1 = el[e]; i1 = e; }
        const float w0 = 1.f / (1.f + expf(v1 - v0)), w1 = 1.f - w0;
        const int e0 = gsel * 8 + i0, e1 = gsel * 8 + i1;
        int lp0 = 0, lp1 = 0;
        if (F.lane < 16) { lp0 = __hip_atomic_fetch_add(lcnt + e0, 1, __ATOMIC_RELAXED, __HIP_MEMORY_SCOPE_WORKGROUP); lp1 = __hip_atomic_fetch_add(lcnt + e1, 1, __ATOMIC_RELAXED, __HIP_MEMORY_SCOPE_WORKGROUP); }
        __syncthreads();
        if (F.tid < 32) gbase[F.tid] = (int)__hip_atomic_fetch_add((unsigned*)(F.ctl + CW_GCNT + 64 * F.tid), (unsigned)lcnt[F.tid], RLX_AGENT);
        __syncthreads();
        if (F.lane < 16) { const int row = row0 + fr; const int p0 = gbase[e0] + lp0, p1 = gbase[e1] + lp1;
            list[e0 * LISTCAP + p0] = row; list[e1 * LISTCAP + p1] = row;
            eid[2 * row] = e0; eid[2 * row + 1] = e1; cw[2 * row] = pg * w0; cw[2 * row + 1] = pg * w1; pos[2 * row] = p0; pos[2 * row + 1] = p1; }
        __syncthreads();
    }
}
struct ExpertTiles {
    int cnt_l, tb_l, T;
    __device__ __forceinline__ void init(gu32* ctl, int lane) {
        const int cnt = lane < 32 ? (int)__hip_atomic_load(ctl + CW_GCNT + 64 * (lane & 31), RLX_AGENT) : 0;
        const int tiles = (cnt + 255) >> 8; int incl = tiles;
#pragma unroll
        for (int o = 1; o < 32; o <<= 1) { const int t = __shfl_up(incl, o); if ((lane & 31) >= o) incl += t; }
        cnt_l = cnt; tb_l = incl - tiles; T = __shfl(incl, 31);
    }
};
constexpr int MISC_ECNT = 80, MISC_ETB = 112, MISC_ET = 144, MISC_NFK = 145, MISC_NSP = 146, MISC_ETP = 147, MISC_EFB = 160, MISC_EHB = 192, MISC_EHALF = 224;
__device__ __forceinline__ void moe_table_to_lds(Frame& F) {
    if (F.wave == 0) { ExpertTiles et; et.init(F.ctl, F.lane); int* mi = (int*)(F.lds + MISC_OFF);
        const int l = F.lane & 31; const int tiles = (et.cnt_l + 255) >> 8; const int half = (F.lane < 32 && tiles >= 1 && (et.cnt_l - 256 * (tiles - 1)) <= 128) ? 1 : 0; const int full = (F.lane < 32 ? tiles : 0) - half;
        int fi = full, hi2 = half;
#pragma unroll
        for (int o = 1; o < 32; o <<= 1) { const int a = __shfl_up(fi, o), b = __shfl_up(hi2, o); if (l >= o) { fi += a; hi2 += b; } }
        if (F.lane < 32) { mi[MISC_ECNT + l] = et.cnt_l; mi[MISC_ETB + l] = et.tb_l; mi[MISC_EFB + l] = fi - full; mi[MISC_EHB + l] = hi2 - half; mi[MISC_EHALF + l] = half; }
        if (F.lane == 31) { const int NF = fi, NH = hi2, G = F.G; const int total = 4 * (NF + NH); const int done = total > 0 ? ((total - 1) / G) * G : 0;
            int FL = 4 * NF - done; FL = FL > 0 ? (FL + 3) >> 2 : 0;
            if (4 * (2 * FL + NH) > G) FL = 0;
            mi[MISC_NFK] = NF - FL; mi[MISC_NSP] = 2 * FL; mi[MISC_ETP] = NF + FL + NH; }
        if (F.lane == 0) mi[MISC_ET] = et.T; }
    __syncthreads();
}
__device__ __forceinline__ void moe_unit_lookup(const int* mi, int idx, int lane, int& e, int& rt, int& half, int& sh) {
    const int NFK = mi[MISC_NFK], NSP = mi[MISC_NSP];
    if (idx < NFK + NSP) { const int ft = idx < NFK ? idx : NFK + ((idx - NFK) >> 1); half = idx < NFK ? 0 : 1; sh = idx < NFK ? 0 : ((idx - NFK) & 1) * 128;
        const unsigned long long mk = __ballot(lane < 32 && mi[MISC_EFB + (lane & 31)] <= ft);
        e = __builtin_amdgcn_readfirstlane(__builtin_popcountll(mk) - 1); rt = __builtin_amdgcn_readfirstlane(mi[MISC_ETB + e] + (ft - mi[MISC_EFB + e])); }
    else { const int k = idx - NFK - NSP; const unsigned long long mk = __ballot(lane < 32 && mi[MISC_EHALF + (lane & 31)] != 0 && mi[MISC_EHB + (lane & 31)] == k);
        e = __builtin_amdgcn_readfirstlane((int)__builtin_ctzll(mk | (1ull << 31))); const int cn = mi[MISC_ECNT + e];
        rt = __builtin_amdgcn_readfirstlane(mi[MISC_ETB + e] + ((cn + 255) >> 8) - 1); half = 1; sh = 0; }
}
template <bool DOWN> struct MoeSched {
    static constexpr bool GATHER = true, HALFABLE = true;
    int G, c, tid; const char* Wb; const int* list; const int* mi;
    __device__ __forceinline__ void init(const unsigned char* lds_generic, const void* Wb_, const int* list_, int G_, int c_, int tid_) { tid = tid_; G = G_; c = c_; Wb = (const char*)Wb_; list = list_; mi = (const int*)(lds_generic + MISC_OFF); }
    __device__ __forceinline__ bool next(int i, g8::Unit& u) const {
        const int units = mi[MISC_ETP] * 4; int L = i * G + c;
        if ((i + 1) * G > units && (G & 7) == 0) { const int per = G >> 3; L = i * G + (c % per) * 8 + c / per; }
        if (L >= units) return false;
        const int pn = L & 3, lane = tid & 63; int e, rt, half, sh;
        moe_unit_lookup(mi, L >> 2, lane, e, rt, half, sh);
        const int tb = __builtin_amdgcn_readfirstlane(mi[MISC_ETB + e]), cn = __builtin_amdgcn_readfirstlane(mi[MISC_ECNT + e]);
        u.pn = pn; u.orow = rt * 256 + sh; u.aux = e | (half << 8); u.Ab = nullptr;
        int R[2], C[2];
#pragma unroll
        for (int i2 = 0; i2 < 2; ++i2) g8::stage_rc(tid * 16 + i2 * 8192, R[i2], C[i2]);
        if (DOWN) { u.Bb = Wb + (size_t)e * (DM * DE * 2) + (size_t)pn * 256 * DE * 2;
#pragma unroll
            for (int h = 0; h < 2; ++h)
#pragma unroll
                for (int i2 = 0; i2 < 2; ++i2) u.aoff[h][i2] = (unsigned)((u.orow + (half ? 0 : h * 128) + R[i2]) * DE + C[i2]) * 2u;
        } else { u.Bb = Wb + (size_t)e * (DM * DM * 2) + (size_t)pn * 256 * DM * 2; const int trow = (rt - tb) * 256 + sh;
#pragma unroll
            for (int h = 0; h < 2; ++h)
#pragma unroll
                for (int i2 = 0; i2 < 2; ++i2) { int r = trow + (half ? 0 : h * 128) + R[i2]; r = r < cn ? r : cn - 1; const int tok = list[e * LISTCAP + r]; u.aoff[h][i2] = (unsigned)(tok * DM + C[i2]) * 2u; }
        }
        return true;
    }
};
struct EpiMoeUp {
    static constexpr bool PERM = true, STORE_ONLY = true;
    h16* H;
    __device__ __forceinline__ bool operator()(g8::f32x4 (&acc)[2][2][4][2], const g8::Unit& u, int wr, int wc, int fr, int fq) const {
        const int row0 = u.orow + wr * 64 + fr, col0 = u.pn * 128 + wc * 32 + 8 * fq;
#pragma unroll
        for (int ai = 0; ai < 2; ++ai) { if (ai == 1 && (u.aux & 256)) break;
#pragma unroll
            for (int m = 0; m < 4; ++m) { float r[8];
#pragma unroll
                for (int n = 0; n < 2; ++n)
#pragma unroll
                    for (int j = 0; j < 4; ++j) { const float g = acc[ai][0][m][n][j], up = acc[ai][1][m][n][j]; r[4 * n + j] = g * fast_sigmoid(g) * up; }
                u32x4 w; w.x = pk_h2(r[0], r[1]); w.y = pk_h2(r[2], r[3]); w.z = pk_h2(r[4], r[5]); w.w = pk_h2(r[6], r[7]);
                *(GAS u32x4*)(H + (size_t)(row0 + ai * 128 + m * 16) * DE + col0) = w; } }
        return false;
    }
};
struct EpiMoeDown {
    static constexpr bool PERM = true, STORE_ONLY = true;
    h16* Y;
    __device__ __forceinline__ bool operator()(g8::f32x4 (&acc)[2][2][4][2], const g8::Unit& u, int wr, int wc, int fr, int fq) const {
        const int row0 = u.orow + wr * 64 + fr, col0 = u.pn * 256 + wc * 32 + 8 * fq;
#pragma unroll
        for (int ai = 0; ai < 2; ++ai) { if (ai == 1 && (u.aux & 256)) break;
#pragma unroll
            for (int m = 0; m < 4; ++m) { h16* rowp = Y + (size_t)(row0 + ai * 128 + m * 16) * DM + col0;
#pragma unroll
                for (int bj = 0; bj < 2; ++bj) { const g8::f32x4 v0 = acc[ai][bj][m][0], v1 = acc[ai][bj][m][1];
                    u32x4 w; w.x = pk_h2(v0[0], v0[1]); w.y = pk_h2(v0[2], v0[3]); w.z = pk_h2(v1[0], v1[1]); w.w = pk_h2(v1[2], v1[3]);
                    *(GAS u32x4*)(rowp + bj * 128) = w; } } }
        return false;
    }
};
__device__ __forceinline__ void p8_final(Frame& F, float* dst) {
    ExpertTiles et; et.init(F.ctl, F.lane);
    const float* mods = (const float*)((F.a->ws) + WS_MODS); const h16* Y = (const h16*)((F.a->ws) + WS_Y); const h16* X1 = (const h16*)((F.a->ws) + WS_X1);
    const int* eid = (const int*)((F.a->ws) + WS_EID); const float* cw = (const float*)((F.a->ws) + WS_CW); const int* pos = (const int*)((F.a->ws) + WS_POS);
    const int gw = F.vcu * NWAVES + F.wave, NGW = F.G * NWAVES;
    for (int m0 = gw * 16; m0 < M; m0 += NGW * 16) {
        const int ea = eid[2 * m0 + (F.lane & 31)], pa = pos[2 * m0 + (F.lane & 31)]; const float wa = cw[2 * m0 + (F.lane & 31)];
        const int slot = __shfl(et.tb_l, ea) * 256 + pa;
        const float* g2 = mods + (m0 / SEQ) * NMODS + 5120; float cg[16], cf[16];
#pragma unroll
        for (int h = 0; h < 2; ++h)
#pragma unroll
            for (int q = 0; q < 2; ++q) { const int idx = h * 512 + F.lane * 8 + q * 4; const f32x4 a = *(const GAS f32x4*)(g2 + idx), b = *(const GAS f32x4*)((F.a->in[19]) + idx);
#pragma unroll
                for (int j = 0; j < 4; ++j) { cg[h * 8 + q * 4 + j] = a[j]; cf[h * 8 + q * 4 + j] = b[j]; } }
#pragma unroll 1
        for (int r4 = 0; r4 < 16; r4 += 4) {
            f16x8 xv[4][2], ya[4][2], yb[4][2]; float c0[4], c1[4];
#pragma unroll
            for (int rr = 0; rr < 4; ++rr) { const int r = r4 + rr; const int s0 = __shfl(slot, 2 * r), s1 = __shfl(slot, 2 * r + 1); c0[rr] = __shfl(wa, 2 * r); c1[rr] = __shfl(wa, 2 * r + 1);
#pragma unroll
                for (int h = 0; h < 2; ++h) { xv[rr][h] = __builtin_nontemporal_load((const GAS f16x8*)(X1 + (size_t)(m0 + r) * DM + h * 512 + F.lane * 8));
                    ya[rr][h] = __builtin_nontemporal_load((const GAS f16x8*)(Y + (size_t)s0 * DM + h * 512 + F.lane * 8)); yb[rr][h] = __builtin_nontemporal_load((const GAS f16x8*)(Y + (size_t)s1 * DM + h * 512 + F.lane * 8)); } }
#pragma unroll
            for (int rr = 0; rr < 4; ++rr) {
                float t[16]; float ss = 0.f;
#pragma unroll
                for (int j = 0; j < 16; ++j) { t[j] = (float)xv[rr][j >> 3][j & 7] + cg[j] * (c0[rr] * (float)ya[rr][j >> 3][j & 7] + c1[rr] * (float)yb[rr][j >> 3][j & 7]); ss += t[j] * t[j]; }
                ss = wave_sum(ss);
                const float rs = 1.0f / sqrtf(ss * (1.0f / DM) + EPS);
                float* orow = dst + (size_t)(m0 + r4 + rr) * DM;
#pragma unroll
                for (int h = 0; h < 2; ++h)
#pragma unroll
                    for (int q = 0; q < 2; ++q) { f32x4 o;
#pragma unroll
                        for (int j = 0; j < 4; ++j) o[j] = t[h * 8 + q * 4 + j] * rs * cf[h * 8 + q * 4 + j];
                        *(GAS f32x4*)(orow + h * 512 + F.lane * 8 + q * 4) = o; }
            }
        }
    }
}
__global__ void __launch_bounds__(NWAVES * 64, 2) mk_fwd(Args args) {
    extern __shared__ __attribute__((aligned(16))) unsigned char lds[];
    Frame F;
    F.lds = (LAS unsigned char*)lds;
    F.MISC = (volatile LAS unsigned*)(F.lds + MISC_OFF);
    F.tid = threadIdx.x; F.lane = F.tid & 63; F.wave = __builtin_amdgcn_readfirstlane(F.tid >> 6);
    F.G = gridDim.x; { const int bx = blockIdx.x; F.vcu = (F.G % 8 == 0) ? (bx % 8) * (F.G / 8) + bx / 8 : bx; }
    F.a = &args; F.ctl = (gu32*)(args.ws + WS_CTL);
    if (F.G == 256) { const bool cv = (F.vcu % 9) == 8; F.nconv = 28; F.conv_rank = cv ? F.vcu / 9 : -1;
        const int xcd = F.vcu >> 5, first = xcd << 5, j = (F.vcu - first) - (F.vcu / 9 - first / 9), label = (xcd & 1) ? 4 + (xcd >> 1) : (xcd >> 1);
        F.gemm_rank = label + 8 * j; }
    else { F.nconv = 0; F.conv_rank = -1; F.gemm_rank = F.vcu; }
    for (int u = F.tid; u < 256; u += NWAVES * 64) F.MISC[u] = 0u;
    __syncthreads();
    XcdBarrier bar = xcd_barrier_post((unsigned*)(F.ctl + CW_BAR), F.MISC + 8);
    const int lo = args.ph_lo, hi = args.ph_hi;
#define IN(k) (lo <= (k) && (k) < hi)
#define BOTH(k) (IN(k) && IN((k) + 1))
#define GRID_BAR() xcd_barrier(bar)
    init_zero(F);
    if (IN(0)) { p0_prologue(F); }
    wait_init(F); xcd_barrier_register(bar);
    if (IN(1)) { wait_mods(F); p1a_rows(F); if (BOTH(1)) { GRID_BAR(); init_done(F); } }
    if (IN(2)) {
        if (F.conv_rank >= 0) p0_convert_experts(F, F.conv_rank * NWAVES + F.wave, F.nconv * NWAVES, 0, I_CONV);
        else {
            DenseSched S; S.init(M, NPROJ, DM, DM, 1, (F.a->ws) + WS_RA, (F.a->ws) + WS_WIN, F.G - F.nconv, F.gemm_rank);
            EpiInProj E{(h16*)((F.a->ws) + WS_Q), (h16*)((F.a->ws) + WS_K), (h16*)((F.a->ws) + WS_V), (h16*)((F.a->ws) + WS_P), (h16*)((F.a->ws) + WS_SGS), (h16*)((F.a->ws) + WS_SGP)};
            g8::gemm_phase(F.lds, (const char*)((F.a->ws) + WS_RA), DM, DM, S, E);
        }
        if (BOTH(2)) GRID_BAR();
    }
    if (IN(3)) { p2_attention_lds(F, (h16*)((F.a->ws) + WS_CAT)); p2_pool(F); if (BOTH(3)) GRID_BAR(); }
    if (IN(4)) {
        DenseSchedT<2> S; S.init(M, DM, PW, DM, 2, (F.a->ws) + WS_CAT, (F.a->ws) + WS_WCAT, F.G, (int)blockIdx.x); EpiBranchFused E{(h16*)((F.a->ws) + WS_RA), (const h16*)((F.a->ws) + WS_SGS), (const h16*)((F.a->ws) + WS_SGP)};
        g8::gemm_phase(F.lds, (const char*)((F.a->ws) + WS_CAT), PW, DM, S, E);
        if (BOTH(4)) GRID_BAR();
    }
    if (IN(5)) {
        DenseSched S; S.init(M, DM, DM, DM, 1, (F.a->ws) + WS_RA, (F.a->ws) + WS_WOUT, F.G, (int)blockIdx.x); EpiOutProj E{(F.a->in[0]), (const float*)((F.a->ws) + WS_MODS), (h16*)((F.a->ws) + WS_X1)};
        g8::gemm_phase(F.lds, (const char*)((F.a->ws) + WS_RA), DM, DM, S, E);
        if (BOTH(5)) GRID_BAR();
    }
    if (IN(6)) { p5_route(F); if (BOTH(6)) GRID_BAR(); }
    if (IN(7)) {
        moe_table_to_lds(F); MoeSched<false> S; S.init(lds, (F.a->ws) + WS_WUP, (const int*)((F.a->ws) + WS_LIST), F.G, F.vcu, F.tid); EpiMoeUp E{(h16*)((F.a->ws) + WS_H)};
        g8::gemm_phase(F.lds, (const char*)((F.a->ws) + WS_RA), DM, DM, S, E);
        if (BOTH(7)) GRID_BAR();
    }
    if (IN(8)) {
        moe_table_to_lds(F); MoeSched<true> S; S.init(lds, (F.a->ws) + WS_WDN, (const int*)((F.a->ws) + WS_LIST), F.G, F.vcu, F.tid); EpiMoeDown E{(h16*)((F.a->ws) + WS_Y)};
        g8::gemm_phase(F.lds, (const char*)((F.a->ws) + WS_H), DE, DE, S, E);
        if (BOTH(8)) GRID_BAR();
    }
    if (IN(9)) { p8_final(F, (F.a->out)); }
#undef IN
#undef BOTH
}

static void launch_mk(void* const* d_in, void* d_out, void* d_ws, hipStream_t stream, int grid, int lo, int hi) {
    Args a{};
    for (int i = 0; i < 20; ++i) a.in[i] = (const float*)d_in[i];
    a.out = (float*)d_out; a.ws = (unsigned char*)d_ws; a.ph_lo = lo; a.ph_hi = hi;
    hipLaunchKernelGGL(mk_fwd, dim3(grid), dim3(NWAVES * 64), LDS_BYTES, stream, a);
}

extern "C" void kernel_launch(void* const* d_in, const int* in_sizes, int n_in, void* d_out, int out_size, void* d_ws, size_t ws_size, hipStream_t stream) {
    static int grid = 0;
    if (grid == 0) {
        if (n_in != 20 || ws_size < WS_END || out_size != M * DM) { fprintf(stderr, "kernel_launch: unexpected n_in %d / ws_size %zu / out_size %d\n", n_in, ws_size, out_size); grid = -1; return; }
        int dev = 0, cus = 0;
        if (hipGetDevice(&dev) != hipSuccess || hipDeviceGetAttribute(&cus, hipDeviceAttributeMultiprocessorCount, dev) != hipSuccess) { grid = -1; return; }
        if (hipFuncSetAttribute((const void*)mk_fwd, hipFuncAttributeMaxDynamicSharedMemorySize, LDS_BYTES) != hipSuccess) { fprintf(stderr, "kernel_launch: hipFuncSetAttribute failed\n"); grid = -1; return; }
        int per_cu = 0;
        if (hipOccupancyMaxActiveBlocksPerMultiprocessor(&per_cu, (const void*)mk_fwd, NWAVES * 64, LDS_BYTES) != hipSuccess || per_cu < 1) { fprintf(stderr, "kernel_launch: the kernel does not fit a CU (occupancy query says %d)\n", per_cu); grid = -1; return; }
        (void)hipGetLastError();
        grid = cus;
    }
    if (grid < 0) return;
    launch_mk(d_in, d_out, d_ws, stream, grid, 0, 10);
}
```

```cpp
#include <hip/hip_runtime.h>
#include <cstdint>
#include <cstdio>
typedef _Float16 h16;
#define GAS __attribute__((address_space(1)))
#define LAS __attribute__((address_space(3)))
typedef unsigned u32x4 __attribute__((ext_vector_type(4)));
typedef unsigned u32x2 __attribute__((ext_vector_type(2)));
typedef float f32x4 __attribute__((ext_vector_type(4)));
typedef float f32x16 __attribute__((ext_vector_type(16)));
typedef _Float16 f16x8 __attribute__((ext_vector_type(8)));
typedef _Float16 f16x4 __attribute__((ext_vector_type(4)));
typedef _Float16 f16x2 __attribute__((ext_vector_type(2)));
typedef GAS unsigned gu32;

constexpr int NB = 16, SEQ = 2048, DM = 1024, M = NB * SEQ, NH = 8, HD = 64, PW = 512, NPROJ = 4096;
constexpr int NEXP = 32, DE = 512, LISTCAP = 32768, NMODS = 6144;
constexpr float C2 = 0.125f * 1.4426950408889634f;
constexpr float EPS = 1e-6f;
constexpr float L2E = 1.4426950408889634f;
constexpr float EXIT_L2 = -152.0f;

constexpr size_t MiB = 1u << 20;
constexpr size_t WS_CTL = 0, CTL_ZERO_BYTES = 2 * MiB;
constexpr size_t WS_MODS = 1 * MiB, WS_EID = 2 * MiB, WS_CW = 2 * MiB + 256 * 1024, WS_POS = 2 * MiB + 512 * 1024;
constexpr size_t WS_LIST = 4 * MiB;
constexpr size_t WS_WIN = 392 * MiB, WS_WBSB = 400 * MiB, WS_WBEFF = 401 * MiB, WS_WOUT = 402 * MiB, WS_WR = 404 * MiB, WS_WUP = 408 * MiB, WS_WDN = 472 * MiB;
constexpr size_t WS_RA = 328 * MiB;
constexpr size_t WS_Q = 8 * MiB, WS_K = 40 * MiB, WS_V = 72 * MiB, WS_P = 104 * MiB;
constexpr size_t WS_SGS = 136 * MiB, WS_SGP = 200 * MiB;
constexpr size_t WS_OSB = 264 * MiB, WS_POOLED = 296 * MiB;
constexpr size_t WS_CAT = 264 * MiB;
constexpr size_t WS_WCAT = 400 * MiB;
constexpr size_t WS_X1 = 264 * MiB;
constexpr size_t WS_Y = 8 * MiB, WS_H = 152 * MiB;
constexpr size_t WS_END = 504 * MiB;
constexpr int CW_TMO = 0;
constexpr int CW_GCNT = 1024;
constexpr int CW_MODS = 3584;
constexpr int CW_BAR = 4096;
constexpr int CW_GRPX = 3656;
constexpr int CW_NONLOCAL = 3640;
constexpr int RING_BYTES = 131072, MISC_OFF = 155648, LDS_BYTES = 163840;
constexpr int NWAVES = 8;

#define RLX_AGENT __ATOMIC_RELAXED, __HIP_MEMORY_SCOPE_AGENT

#define LDS_WAIT() asm volatile("s_waitcnt lgkmcnt(0)" ::: "memory")
#define VM_WAIT() asm volatile("s_waitcnt vmcnt(0)" ::: "memory")

__device__ __forceinline__ float wave_sum(float v) {
#pragma unroll
    for (int o = 1; o < 64; o <<= 1) v += __shfl_xor(v, o);
    return v;
}
__device__ __forceinline__ unsigned pk_h2(float lo, float hi) { f16x2 v = {(_Float16)lo, (_Float16)hi}; return __builtin_bit_cast(unsigned, v); }
__device__ __forceinline__ float fast_sigmoid(float v) { return __builtin_amdgcn_rcpf(1.f + __builtin_amdgcn_exp2f(-v * L2E)); }

#define XB_TMO      128
#define XB_XCNT(j)  (256  + 64 * (j))
#define XB_XSUB(j)  (1280 + 64 * (j))
#define XB_XGEN(j)  (2304 + 64 * (j))
#define XB_TOP      3328
#define XB_TOPGEN   3392
#define XCD_BAR_WORDS 3456
#define XB_SPIN_CAP (1u << 18)
__device__ __forceinline__ unsigned xb_ld(unsigned* p)              { return __hip_atomic_load(p, __ATOMIC_RELAXED, __HIP_MEMORY_SCOPE_AGENT); }
__device__ __forceinline__ unsigned xb_add(unsigned* p, unsigned v) { return __hip_atomic_fetch_add(p, v, __ATOMIC_RELAXED, __HIP_MEMORY_SCOPE_AGENT); }
__device__ __forceinline__ unsigned xb_xcc_id() { return (unsigned)__builtin_amdgcn_s_getreg((3 << 11) | 20) & 0xFu; }
#define XB_SPIN(cond, bar) do { unsigned _sp = 0; while (cond) { __builtin_amdgcn_s_sleep(1); \
    if ((++_sp & 255u) == 0u) { if (xb_ld(&(bar)[XB_TMO])) break; if (_sp > XB_SPIN_CAP) { atomicAdd(&(bar)[XB_TMO], 1u); break; } } } } while (0)
struct XcdBarrier { unsigned* bar; unsigned x; volatile LAS unsigned* st; };
__device__ __forceinline__ XcdBarrier xcd_barrier_post(unsigned* bar, volatile LAS unsigned* st) {
    XcdBarrier b; b.bar = bar; b.x = xb_xcc_id(); b.st = st;
    if (threadIdx.x == 0) (void)xb_add(&bar[XB_XCNT(b.x)], 1u);
    return b;
}
__device__ __forceinline__ void xcd_barrier_complete(unsigned* bar, unsigned x, unsigned& nloc, unsigned& nx) {
    const unsigned G = gridDim.x * gridDim.y * gridDim.z;
    unsigned sum, cnt, mine, sp = 0u;
    for (;;) {
        sum = 0u; cnt = 0u; mine = 0u;
#pragma unroll
        for (unsigned j = 0; j < 16; ++j) { const unsigned c = xb_ld(&bar[XB_XCNT(j)]); sum += c; cnt += (c > 0u) ? 1u : 0u; mine = (j == x) ? c : mine; }
        if (sum == G) break;
        __builtin_amdgcn_s_sleep(1);
        if ((++sp & 255u) == 0u) { if (xb_ld(&bar[XB_TMO])) break; if (sp > XB_SPIN_CAP) { atomicAdd(&bar[XB_TMO], 1u); break; } }
    }
    nloc = mine > 0u ? mine : 1u; nx = cnt > 0u ? cnt : 1u;
}
__device__ __forceinline__ void xcd_barrier(const XcdBarrier& b, const bool early_wb = false) {
    asm volatile("s_waitcnt vmcnt(0)" ::: "memory");
    __syncthreads();
    if (threadIdx.x == 0) {
        unsigned* bar = b.bar;
        __builtin_amdgcn_s_waitcnt(0);
        unsigned nloc = b.st[0], nx = b.st[1];
        if (nloc == 0u) { xcd_barrier_complete(bar, b.x, nloc, nx); b.st[0] = nloc; b.st[1] = nx; }
        const unsigned old = xb_add(&bar[XB_XSUB(b.x)], 1u);
        const unsigned gen = old / nloc;
        if (early_wb && old == gen * nloc && nloc > 1u) { __builtin_amdgcn_fence(__ATOMIC_RELEASE, "agent"); asm volatile("s_waitcnt vmcnt(0)" ::: "memory"); }
        if (old + 1u == (gen + 1u) * nloc) {
            __builtin_amdgcn_fence(__ATOMIC_RELEASE, "agent");
            asm volatile("s_waitcnt vmcnt(0)" ::: "memory");
            const unsigned og = xb_add(&bar[XB_TOP], 1u);
            const unsigned tg = og / nx;
            if (og + 1u == (tg + 1u) * nx) xb_add(&bar[XB_TOPGEN], 1u);
            else XB_SPIN(xb_ld(&bar[XB_TOPGEN]) == tg, bar);
            xb_add(&bar[XB_XGEN(b.x)], 1u);
            __builtin_amdgcn_fence(__ATOMIC_ACQUIRE, "agent");
            asm volatile("s_waitcnt vmcnt(0)" ::: "memory");
        } else {
            __builtin_amdgcn_fence(__ATOMIC_ACQUIRE, "agent");
            XB_SPIN(xb_ld(&bar[XB_XGEN(b.x)]) == gen, bar);
            asm volatile("s_waitcnt vmcnt(0)" ::: "memory");
        }
    }
    __syncthreads();
}
__device__ __forceinline__ void xcd_barrier_local(const XcdBarrier& b, unsigned* wait_word = nullptr, unsigned wait_min = 0u) {
    asm volatile("s_waitcnt vmcnt(0)" ::: "memory");
    __syncthreads();
    if (threadIdx.x == 0) {
        unsigned* bar = b.bar;
        __builtin_amdgcn_s_waitcnt(0);
        unsigned nloc = b.st[0], nx = b.st[1];
        if (nloc == 0u) { xcd_barrier_complete(bar, b.x, nloc, nx); b.st[0] = nloc; b.st[1] = nx; }
        const unsigned old = xb_add(&bar[XB_XSUB(b.x)], 1u);
        const unsigned gen = old / nloc;
        const bool lastone = old + 1u == (gen + 1u) * nloc;
        if (lastone) xb_add(&bar[XB_XGEN(b.x)], 1u);
        __builtin_amdgcn_fence(__ATOMIC_ACQUIRE, "agent");
        if (!lastone) XB_SPIN(xb_ld(&bar[XB_XGEN(b.x)]) == gen, bar);
        if (wait_word != nullptr) XB_SPIN(xb_ld(wait_word) < wait_min, bar);
        asm volatile("s_waitcnt vmcnt(0)" ::: "memory");
    }
    __syncthreads();
}
namespace g8 {
#define G8_LAS __attribute__((address_space(3)))
typedef _Float16 f16x8 __attribute__((ext_vector_type(8)));
typedef float f32x4 __attribute__((ext_vector_type(4)));
typedef unsigned u32x4 __attribute__((ext_vector_type(4)));
typedef unsigned u32x2 __attribute__((ext_vector_type(2)));
typedef _Float16 f16x2 __attribute__((ext_vector_type(2)));
constexpr int BM = 256, BK = 64, HALF = 128, HTB = HALF * BK * 2  , STAGE_BYTES = 8 * HTB;

__host__ __device__ __forceinline__ int lds_byte(int r, int c) { const int st = (r >> 4) * 2 + (c >> 5), rr = r & 15, cc = c & 31, ob = rr * 64 + cc * 2; return st * 1024 + (ob ^ (((ob >> 9) & 1) << 5)); }
__host__ __device__ __forceinline__ void stage_rc(int b, int& R, int& C) { const int st = b / 1024, sb = b % 1024, swz = sb ^ (((sb >> 9) & 1) << 5); R = (st >> 1) * 16 + swz / 64; C = (st & 1) * 32 + (swz % 64) / 2; }
__host__ __device__ __forceinline__ int perm32(int rho) { const int n = rho >> 4, i = rho & 15; return 8 * (i >> 2) + 4 * n + (i & 3); }

__device__ __forceinline__ unsigned pk_h2(float lo, float hi) { f16x2 v = {(_Float16)lo, (_Float16)hi}; return __builtin_bit_cast(unsigned, v); }

struct Unit {
    unsigned aoff[2][2];
    const char* Ab;
    const char* Bb;
    int orow;
    int pn;
    int aux;
};

template <class Epi, class Sched>
__device__ __forceinline__ void gemm_phase(G8_LAS unsigned char* lds, const char* Abase, const int K, const int LD, Sched& S, const Epi& E) {
    const int tid = threadIdx.x, wid = __builtin_amdgcn_readfirstlane(tid >> 6), lane = tid & 63, wr = wid >> 2, wc = wid & 3, fr = lane & 15, fq = lane >> 4;
    const int nt = K / BK;
    unsigned voffB[2], voffA[2][2];
#pragma unroll
    for (int i = 0; i < 2; ++i) { int R, C; stage_rc(tid * 16 + i * 8192, R, C); const int Rb = Epi::PERM ? ((R & ~31) + perm32(R & 31)) : R; voffB[i] = (unsigned)(Rb * LD + C) * 2u;
        voffA[0][i] = (unsigned)(R * LD + C) * 2u; voffA[1][i] = (unsigned)((R + HALF) * LD + C) * 2u; }
    constexpr bool GA = Sched::GATHER, HS = Sched::HALFABLE;
    const size_t kstep = (size_t)(BK * 2);
    const size_t hstep = (size_t)HALF * LD * 2;
    const unsigned ldsw = (unsigned)wid * 1024u;
    const int aoff = lds_byte(wr * 64 + fr, fq * 8), boff = lds_byte(wc * 32 + fr, fq * 8);
#define G8_SA(b, h) (((b) * 2 + (h)) * HTB)
#define G8_SB(b, h) ((4 + (b) * 2 + (h)) * HTB)
#define G8_STAGE(bufoff, gbase, voff) do { _Pragma("unroll") for (int _i = 0; _i < 2; ++_i) \
        __builtin_amdgcn_global_load_lds((const unsigned*)((const char*)(gbase) + (voff)[_i]), (G8_LAS unsigned*)(lds + (bufoff) + ldsw + _i * 8192), 16, 0, 0); } while (0)
#define G8_LDA(dst, b, h) do { _Pragma("unroll") for (int m = 0; m < 4; ++m) _Pragma("unroll") for (int k = 0; k < 2; ++k) dst[m][k] = *(const G8_LAS f16x8*)(lds + G8_SA(b, h) + aoff + m * 2048 + k * 1024); } while (0)
#define G8_LDB(dst, b, h) do { _Pragma("unroll") for (int n = 0; n < 2; ++n) _Pragma("unroll") for (int k = 0; k < 2; ++k) dst[n][k] = *(const G8_LAS f16x8*)(lds + G8_SB(b, h) + boff + n * 2048 + k * 1024); } while (0)
#define G8_MMA(ai, bj, At, Bt) do { __builtin_amdgcn_s_setprio(1); _Pragma("unroll") for (int m = 0; m < 4; ++m) _Pragma("unroll") for (int n = 0; n < 2; ++n) _Pragma("unroll") for (int k = 0; k < 2; ++k) \
        acc[ai][bj][m][n] = __builtin_amdgcn_mfma_f32_16x16x32_f16(Bt[n][k], At[m][k], acc[ai][bj][m][n], 0, 0, 0); __builtin_amdgcn_s_setprio(0); } while (0)
#define G8_WAIT_V(n) asm volatile("s_waitcnt vmcnt(" #n ")" ::: "memory")
#define G8_WAIT_L(n) asm volatile("s_waitcnt lgkmcnt(" #n ")" ::: "memory")
#define G8_BAR __builtin_amdgcn_s_barrier()
#define G8_SCHED __builtin_amdgcn_sched_barrier(0)
    Unit cur, nxt; int ui = 0;
    if (!S.next(0, cur)) return;
    f32x4 acc[2][2][4][2];
#pragma unroll
    for (int a = 0; a < 2; ++a)
#pragma unroll
        for (int b = 0; b < 2; ++b)
#pragma unroll
            for (int m = 0; m < 4; ++m)
#pragma unroll
                for (int n = 0; n < 2; ++n) acc[a][b][m][n] = (f32x4){0.f, 0.f, 0.f, 0.f};
    f16x8 At[4][2], B0[2][2], B1[2][2];
    G8_STAGE(G8_SB(0, 0), cur.Bb, voffB); G8_STAGE(G8_SB(0, 1), cur.Bb + hstep, voffB); G8_STAGE(G8_SA(0, 0), (GA ? Abase : cur.Ab), (GA ? cur.aoff[0] : voffA[0])); G8_STAGE(G8_SA(0, 1), (GA ? Abase : cur.Ab), (GA ? cur.aoff[1] : voffA[1]));
    if (wr == 1) G8_BAR;
    G8_WAIT_V(2); G8_BAR;
    G8_STAGE(G8_SB(1, 0), cur.Bb + kstep, voffB); G8_STAGE(G8_SA(1, 0), (GA ? Abase : cur.Ab) + kstep, (GA ? cur.aoff[0] : voffA[0])); G8_STAGE(G8_SB(1, 1), cur.Bb + hstep + kstep, voffB);
    G8_WAIT_V(6); G8_BAR;
    for (;;) {
        const bool has_next = S.next(ui + 1, nxt);
        if (!has_next) nxt = cur;
        for (int t = 0; t < nt; t += 2) {
            const bool last = (t == nt - 2);
            const char* cAb = GA ? Abase : cur.Ab; const char* nAb = GA ? Abase : nxt.Ab;
            const char* a1 = cAb + (size_t)(t + 1) * kstep;
            const char* a2 = last ? nAb : cAb + (size_t)(t + 2) * kstep;
            const char* b2 = last ? nxt.Bb : cur.Bb + (size_t)(t + 2) * kstep;
            const char* a3 = a2 + kstep; const char* b3 = b2 + kstep;
            unsigned o2[2][2];
#pragma unroll
            for (int h = 0; h < 2; ++h)
#pragma unroll
                for (int i = 0; i < 2; ++i) o2[h][i] = GA ? (last ? nxt.aoff[h][i] : cur.aoff[h][i]) : voffA[h][i];
            G8_LDB(B0, 0, 0); G8_LDB(B1, 0, 1); G8_SCHED; G8_LDA(At, 0, 0); G8_STAGE(G8_SA(1, 1), a1, (GA ? cur.aoff[1] : voffA[1]));
            G8_WAIT_V(8); G8_WAIT_L(0); G8_BAR; G8_MMA(0, 0, At, B0); G8_MMA(0, 1, At, B1); G8_BAR; G8_SCHED;
            if (!HS || !(cur.aux & 256)) { G8_LDA(At, 0, 1); } G8_STAGE(G8_SB(0, 0), b2, voffB); G8_STAGE(G8_SB(0, 1), b2 + hstep, voffB); G8_STAGE(G8_SA(0, 0), a2, o2[0]);
            G8_WAIT_V(8); G8_WAIT_L(0); G8_BAR; if (!HS || !(cur.aux & 256)) { G8_MMA(1, 0, At, B0); G8_MMA(1, 1, At, B1); } G8_BAR; G8_SCHED;
            G8_LDB(B0, 1, 0); G8_LDB(B1, 1, 1); G8_SCHED; G8_LDA(At, 1, 0); G8_STAGE(G8_SA(0, 1), a2, o2[1]);
            G8_WAIT_V(8); G8_WAIT_L(0); G8_BAR; G8_MMA(0, 0, At, B0); G8_MMA(0, 1, At, B1); G8_BAR; G8_SCHED;
            if (!HS || !(cur.aux & 256)) { G8_LDA(At, 1, 1); } G8_STAGE(G8_SB(1, 0), b3, voffB); G8_STAGE(G8_SB(1, 1), b3 + hstep, voffB); G8_STAGE(G8_SA(1, 0), a3, o2[0]);
            G8_WAIT_V(8); G8_WAIT_L(0); G8_BAR; if (!HS || !(cur.aux & 256)) { G8_MMA(1, 0, At, B0); G8_MMA(1, 1, At, B1); } G8_BAR; G8_SCHED;
        }
        if (wr == 0) G8_BAR;
        const bool keep = E(acc, cur, wr, wc, fr, fq);
        if (!has_next) break;
        if (!keep)
#pragma unroll
        for (int a = 0; a < 2; ++a)
#pragma unroll
            for (int b = 0; b < 2; ++b)
#pragma unroll
                for (int m = 0; m < 4; ++m)
#pragma unroll
                    for (int n = 0; n < 2; ++n) acc[a][b][m][n] = (f32x4){0.f, 0.f, 0.f, 0.f};
        cur = nxt; ++ui;
        if (wr == 1) G8_BAR;
    }
    G8_WAIT_V(0);
    G8_BAR;
#undef G8_SA
#undef G8_SB
#undef G8_STAGE
#undef G8_LDA
#undef G8_LDB
#undef G8_MMA
#undef G8_WAIT_V
#undef G8_WAIT_L
#undef G8_BAR
#undef G8_SCHED
}
}
struct Args { const float* in[20]; float* out; unsigned char* ws; int ph_lo, ph_hi; };
struct Frame {
    LAS unsigned char* lds;
    volatile LAS unsigned* MISC;
    gu32* ctl;
    int tid, lane, wave, vcu, G;
    int nconv, conv_rank, gemm_rank;
    const Args* a;
};

struct TItem { const float* src; h16* dst; int ldw, ldt; float sc; };
__device__ __forceinline__ void p0_item_load(const TItem& t, f32x4 (&v)[8], int lane) {
#pragma unroll
    for (int i = 0; i < 8; ++i) v[i] = __builtin_nontemporal_load((const GAS f32x4*)(t.src + (size_t)(8 * i + (lane >> 3)) * t.ldw + (lane & 7) * 4));
}
__device__ __forceinline__ void p0_item_store(const TItem& t, const f32x4 (&v)[8], LAS float* scr, int lane) {
#pragma unroll
    for (int i = 0; i < 8; ++i) { const int kk = 8 * i + (lane >> 3), n = (lane & 7) * 4;
        scr[(n + 0) * 65 + kk] = v[i].x; scr[(n + 1) * 65 + kk] = v[i].y; scr[(n + 2) * 65 + kk] = v[i].z; scr[(n + 3) * 65 + kk] = v[i].w; }
    LDS_WAIT(); asm volatile("" ::: "memory");
#pragma unroll
    for (int j = 0; j < 4; ++j) { const int n = 8 * j + (lane >> 3), c = lane & 7; const LAS float* s = scr + n * 65 + 8 * c;
        u32x4 o; o.x = pk_h2(s[0] * t.sc, s[1] * t.sc); o.y = pk_h2(s[2] * t.sc, s[3] * t.sc); o.z = pk_h2(s[4] * t.sc, s[5] * t.sc); o.w = pk_h2(s[6] * t.sc, s[7] * t.sc);
        *(GAS u32x4*)(t.dst + (size_t)n * t.ldt + 8 * c) = o; }
    LDS_WAIT(); asm volatile("" ::: "memory");
}
constexpr int I_IN = (DM / 64) * (NPROJ / 32), I_BSB = (PW / 64) * (DM / 32), I_OUT = (DM / 64) * (DM / 32), I_DENSE = I_IN + I_BSB + I_OUT;
constexpr int I_EG = (DM / 64) * (DE / 32), I_ED = (DE / 64) * (DM / 32), I_E = 2 * I_EG + I_ED, I_EXP = NEXP * I_E;
constexpr int I_EFF = PW * (DM / 64);
constexpr int I_CONV = 23 * I_E;
__device__ __forceinline__ void p0_dense_decode(const Frame& F, int r, TItem& t) {
    const float* W; h16* WT; int ldw, ldt, k0, n0, drow0; float sc = 1.f;
    if (r < I_IN) { const int nblk = NPROJ / 32; W = (F.a->in[6]); ldw = NPROJ; WT = (h16*)((F.a->ws) + WS_WIN); ldt = DM; k0 = 64 * (r / nblk); n0 = 32 * (r % nblk);
        sc = n0 < 512 ? C2 : n0 >= 2048 ? -L2E : 1.f;
        if (n0 < 2048) drow0 = n0; else { const int c = (n0 - 2048) & 1023, isp = n0 >= 3072; drow0 = 2048 + 256 * (c >> 7) + 128 * isp + (c & 127); } }
    else if ((r -= I_IN) < I_BSB) { const int nblk = DM / 32; W = (F.a->in[9]); ldw = DM; WT = (h16*)((F.a->ws) + WS_WCAT); ldt = DM; k0 = 64 * (r / nblk); n0 = 32 * (r % nblk); drow0 = n0; }
    else { r -= I_BSB; const int nblk = DM / 32; W = (F.a->in[11]); ldw = DM; WT = (h16*)((F.a->ws) + WS_WOUT); ldt = DM; k0 = 64 * (r / nblk); n0 = 32 * (r % nblk); drow0 = n0; }
    t.src = W + (size_t)k0 * ldw + n0; t.dst = WT + (size_t)drow0 * ldt + k0; t.ldw = ldw; t.ldt = ldt; t.sc = sc;
}
__device__ __forceinline__ void p0_expert_decode(const Frame& F, int r, TItem& t) {
    const float* W; h16* WT; int ldw, ldt, k0, n0, drow0;
    const int e = r / I_E; int q = r % I_E;
    if (q < 2 * I_EG) { const int isup = q >= I_EG; q -= isup * I_EG; const int nblk = DE / 32; k0 = 64 * (q / nblk); n0 = 32 * (q % nblk);
        W = (isup ? (F.a->in[17]) : (F.a->in[16])) + (size_t)e * DM * DE; ldw = DE; WT = (h16*)((F.a->ws) + WS_WUP) + (size_t)e * DM * DM; ldt = DM; drow0 = 256 * (n0 >> 7) + 128 * isup + (n0 & 127); }
    else { q -= 2 * I_EG; const int nblk = DM / 32; k0 = 64 * (q / nblk); n0 = 32 * (q % nblk); W = (F.a->in[18]) + (size_t)e * DE * DM; ldw = DM; WT = (h16*)((F.a->ws) + WS_WDN) + (size_t)e * DM * DE; ldt = DE; drow0 = n0; }
    t.src = W + (size_t)k0 * ldw + n0; t.dst = WT + (size_t)drow0 * ldt + k0; t.ldw = ldw; t.ldt = ldt; t.sc = 1.f;
}
__device__ __forceinline__ void p0_convert_experts(Frame& F, int cw, int ncw, int i_lo, int i_hi) {
    LAS float* scr = (LAS float*)(F.lds + F.wave * 8320);
    const int rounds = ((i_hi - i_lo + ncw - 1) / ncw + 2) / 3 * 3;
    TItem tA, tB, tC; f32x4 vA[8], vB[8], vC[8];
#define P0_CLAMP(k) ((i_lo + (k) * ncw + cw) < i_hi ? (i_lo + (k) * ncw + cw) : i_hi - 1)
    p0_expert_decode(F, P0_CLAMP(0), tA); p0_item_load(tA, vA, F.lane);
    p0_expert_decode(F, P0_CLAMP(1), tB); p0_item_load(tB, vB, F.lane);
    p0_expert_decode(F, P0_CLAMP(2), tC); p0_item_load(tC, vC, F.lane);
#pragma unroll 1
    for (int k = 3; k < rounds + 3; k += 3) {
        p0_item_store(tA, vA, scr, F.lane); p0_expert_decode(F, P0_CLAMP(k), tA); p0_item_load(tA, vA, F.lane);
        p0_item_store(tB, vB, scr, F.lane); p0_expert_decode(F, P0_CLAMP(k + 1), tB); p0_item_load(tB, vB, F.lane);
        p0_item_store(tC, vC, scr, F.lane); p0_expert_decode(F, P0_CLAMP(k + 2), tC); p0_item_load(tC, vC, F.lane);
    }
#undef P0_CLAMP
}
__device__ __forceinline__ void p0_mods(Frame& F) {
    const int jb = F.vcu % (NMODS / 64), kh = F.vcu / (NMODS / 64), j0 = jb * 64, kbase = kh * 512;
    LAS float* cat = (LAS float*)F.lds;
    LAS float* red = (LAS float*)(F.lds + 32768);
    for (int idx = F.tid; idx < NB * 512; idx += NWAVES * 64) { const int b = idx >> 9, k = idx & 511; const float v = (F.a->in[1])[b * DM + kbase + k]; cat[k * 16 + b] = v / (1.f + expf(-v)); }
    __syncthreads();
    float acc[16];
#pragma unroll
    for (int b = 0; b < 16; ++b) acc[b] = 0.f;
    const float* wp = (F.a->in[4]) + (size_t)(kbase + F.wave * 64) * NMODS + j0 + F.lane;
    {   const int kk = 0;
        float wv[64];
#pragma unroll
        for (int u = 0; u < 64; ++u) wv[u] = __builtin_nontemporal_load(wp + (size_t)(kk + u) * NMODS);
#pragma unroll
        for (int u = 0; u < 64; ++u) { const LAS f32x4* cp = (const LAS f32x4*)(cat + (F.wave * 64 + kk + u) * 16);
#pragma unroll
            for (int q = 0; q < 4; ++q) { const f32x4 cv = cp[q]; acc[4 * q] += cv.x * wv[u]; acc[4 * q + 1] += cv.y * wv[u]; acc[4 * q + 2] += cv.z * wv[u]; acc[4 * q + 3] += cv.w * wv[u]; } }
    }
#pragma unroll
    for (int b = 0; b < 16; ++b) red[(F.wave * 16 + b) * 64 + F.lane] = acc[b];
    __syncthreads();
    for (int o = F.tid; o < 16 * 64; o += NWAVES * 64) { const int b = o >> 6, j = o & 63; float s = kh == 0 ? (F.a->in[5])[j0 + j] : 0.f;
#pragma unroll
        for (int w = 0; w < 8; ++w) s += red[(w * 16 + b) * 64 + j];
        atomicAdd((float*)((F.a->ws) + WS_MODS) + b * NMODS + j0 + j, s); }
    VM_WAIT();
    __syncthreads();
    if (F.tid == 0) __hip_atomic_fetch_add((unsigned*)(F.ctl + CW_MODS), 1u, RLX_AGENT);
}
__device__ __forceinline__ void p0_prologue(Frame& F) {
    if (F.vcu < 2 * (NMODS / 64)) p0_mods(F);
    {
        h16* wr = (h16*)((F.a->ws) + WS_WR);
        for (int item = F.vcu * NWAVES + F.wave; item < 1024; item += F.G * NWAVES) { const int n = item >> 4, k = (item & 15) * 64 + F.lane; float v = 0.f;
            if (n < 4) v = (F.a->in[12])[k * 4 + n]; else if (n < 36) v = (F.a->in[14])[((size_t)((n - 4) >> 3) * DM + k) * 8 + ((n - 4) & 7)];
            wr[n * DM + k] = (h16)v; }
    }
    LAS float* scr = (LAS float*)(F.lds + F.wave * 8320);
    const int gw = F.vcu * NWAVES + F.wave;
    const int NGW = F.G * NWAVES, B1 = NGW / 2;
    for (int it = gw; it < I_DENSE; it += NGW) { TItem t; f32x4 v[8]; p0_dense_decode(F, it, t); p0_item_load(t, v, F.lane); p0_item_store(t, v, scr, F.lane); }
    p0_convert_experts(F, gw, NGW, F.nconv ? I_CONV : 0, I_EXP);
    h16* WBEFF = (h16*)((F.a->ws) + WS_WCAT) + PW;
    for (int r = gw - B1; r >= 0 && r < (PW / 8) * (DM / 64); r += NGW) {
        const int r8 = r / (DM / 64), nb = r % (DM / 64), g = r8 >> 4; const float* pw = (F.a->in[7]) + (size_t)(r8 * 8) * 128; const float* ps = (F.a->in[8]) + g * 128;
        const float* wb = (F.a->in[10]) + (size_t)(g * 128) * DM + nb * 64 + F.lane; float acc[8];
#pragma unroll
        for (int c = 0; c < 8; ++c) acc[c] = 0.f;
#pragma unroll 1
        for (int d0 = 0; d0 < 128; d0 += 64) { float wv[64];
#pragma unroll
            for (int d = 0; d < 64; ++d) wv[d] = wb[(size_t)(d0 + d) * DM];
#pragma unroll
            for (int d = 0; d < 64; ++d) wv[d] *= ps[d0 + d];
#pragma unroll
            for (int d = 0; d < 64; ++d)
#pragma unroll
                for (int c = 0; c < 8; ++c) acc[c] += pw[c * 128 + d0 + d] * wv[d]; }
        u32x4 o; o.x = pk_h2(acc[0], acc[1]); o.y = pk_h2(acc[2], acc[3]); o.z = pk_h2(acc[4], acc[5]); o.w = pk_h2(acc[6], acc[7]);
        *(GAS u32x4*)(WBEFF + (size_t)(nb * 64 + F.lane) * DM + r8 * 8) = o;
    }
}
__device__ __forceinline__ void rownorm_mod_row(const float* xr, const float* g, const float* mb, int shift_off, int scale_off, h16* orow, int lane) {
    f32x4 v[4]; float ss = 0.f;
#pragma unroll
    for (int j = 0; j < 4; ++j) { v[j] = *(const GAS f32x4*)(xr + j * 256 + lane * 4); ss += (v[j].x * v[j].x + v[j].y * v[j].y) + (v[j].z * v[j].z + v[j].w * v[j].w); }
    ss = wave_sum(ss);
    const float rs = 1.0f / sqrtf(ss * (1.0f / DM) + EPS);
#pragma unroll
    for (int j = 0; j < 4; ++j) { const int idx = j * 256 + lane * 4;
        const f32x4 gg = *(const GAS f32x4*)(g + idx), sc = *(const GAS f32x4*)(mb + scale_off + idx), sh = *(const GAS f32x4*)(mb + shift_off + idx);
        u32x2 o; o.x = pk_h2(v[j].x * rs * gg.x * (1.f + sc.x) + sh.x, v[j].y * rs * gg.y * (1.f + sc.y) + sh.y);
        o.y = pk_h2(v[j].z * rs * gg.z * (1.f + sc.z) + sh.z, v[j].w * rs * gg.w * (1.f + sc.w) + sh.w);
        *(GAS u32x2*)(orow + idx) = o; }
}
__device__ __forceinline__ void wait_mods(Frame& F) {
    if (F.tid == 0) { unsigned sp = 0; const unsigned want = 2u * (NMODS / 64);
        while (__hip_atomic_load((unsigned*)(F.ctl + CW_MODS), RLX_AGENT) < want) { __builtin_amdgcn_s_sleep(2); if (++sp > (1u << 20)) { __hip_atomic_store((unsigned*)(F.ctl + CW_TMO), 1u, RLX_AGENT); break; } }
        __builtin_amdgcn_fence(__ATOMIC_ACQUIRE, "agent"); asm volatile("s_waitcnt vmcnt(0)" ::: "memory"); }
    __syncthreads();
}
__device__ __forceinline__ void p1a_rows(Frame& F) {
    const int gw = F.vcu * NWAVES + F.wave, NGW = F.G * NWAVES; const float* mods = (const float*)((F.a->ws) + WS_MODS); h16* Hh = (h16*)((F.a->ws) + WS_RA);
    for (int m0 = gw * 16; m0 < M; m0 += NGW * 16) {
        const float* mb = mods + (m0 / SEQ) * NMODS; f32x4 ca[4], cb[4];
#pragma unroll
        for (int j = 0; j < 4; ++j) { const int idx = j * 256 + F.lane * 4; const f32x4 gg = *(const GAS f32x4*)((F.a->in[2]) + idx), sc = *(const GAS f32x4*)(mb + 1024 + idx); cb[j] = *(const GAS f32x4*)(mb + idx); ca[j] = gg * (sc + 1.f); }
#pragma unroll 1
        for (int r8 = 0; r8 < 16; r8 += 8) {
            f32x4 v[8][4];
#pragma unroll
            for (int rr = 0; rr < 8; ++rr)
#pragma unroll
                for (int j = 0; j < 4; ++j) v[rr][j] = __builtin_nontemporal_load((const GAS f32x4*)((F.a->in[0]) + (size_t)(m0 + r8 + rr) * DM + j * 256 + F.lane * 4));
#pragma unroll
            for (int rr = 0; rr < 8; ++rr) { float ss = 0.f;
#pragma unroll
                for (int j = 0; j < 4; ++j) ss += (v[rr][j].x * v[rr][j].x + v[rr][j].y * v[rr][j].y) + (v[rr][j].z * v[rr][j].z + v[rr][j].w * v[rr][j].w);
                ss = wave_sum(ss);
                const float rs = 1.0f / sqrtf(ss * (1.0f / DM) + EPS);
#pragma unroll
                for (int j = 0; j < 4; ++j) { const f32x4 h = v[rr][j] * rs * ca[j] + cb[j]; u32x2 o; o.x = pk_h2(h.x, h.y); o.y = pk_h2(h.z, h.w);
                    *(GAS u32x2*)(Hh + (size_t)(m0 + r8 + rr) * DM + j * 256 + F.lane * 4) = o; } }
        }
    }
}

template <int parts> struct DenseSchedT {
    static constexpr bool GATHER = false, HALFABLE = false;
    int nM, nN, nwg, G, c, K, LD; const char* Bt; const char* A;
    __device__ __forceinline__ void init(int M_, int N_, int K_, int LD_, int, const void* A_, const void* Bt_, int G_, int c_) { nM = M_ / 256; nN = N_ / 256; nwg = nM * nN; G = G_; c = c_; K = K_; LD = LD_; A = (const char*)A_; Bt = (const char*)Bt_; }
    __device__ __forceinline__ bool next(int i, g8::Unit& u) const {
        const int part = i % parts; const long L = (long)(i / parts) * G + c; if (L >= nwg) return false;
        int wgid = (int)L; { const int q = nwg / 8, r = nwg % 8, xcd = wgid % 8, off = wgid / 8; wgid = (xcd < r ? xcd * (q + 1) : r * (q + 1) + (xcd - r) * q) + off; }
        const int nig = 8 * nN, gid = wgid / nig, fm = gid * 8, gsz = (nM - fm) < 8 ? (nM - fm) : 8;
        const int pm = fm + ((wgid % nig) % gsz), pn = (wgid % nig) / gsz;
        u.aoff[0][0] = 0u; u.aoff[0][1] = 0u; u.aoff[1][0] = 0u; u.aoff[1][1] = 0u;
        u.pn = pn; u.orow = pm * 256; u.aux = part; u.Bb = Bt + ((size_t)pn * 256 * LD + (size_t)part * K) * 2; u.Ab = A + ((size_t)pm * 256 * LD + (size_t)part * K) * 2;
        return true;
    }
};
typedef DenseSchedT<1> DenseSched;
struct InProjSched {
    static constexpr bool GATHER = false, HALFABLE = false;
    int x, j, n; const char* Bt; const char* A;
    __device__ __forceinline__ void init(const void* A_, const void* Bt_, int x_, int j_) { x = x_; j = j_; n = (x_ & 1) ? 28 : 29; A = (const char*)A_; Bt = (const char*)Bt_; }
    __device__ __forceinline__ bool next(int i, g8::Unit& u) const {
        int chunk = x, off = j + i * n, aux = 0;
        if (off >= ((x & 1) ? 252 : 256)) { if ((x & 1) || i != 8 || j < 24 || j >= 28) return false; chunk = x + 1; off = 252 + (j - 24); aux = 2; }
        const int nN = NPROJ / 256, wgid = chunk * 256 + off, nig = 8 * nN, gid = wgid / nig, fm = gid * 8, pm = fm + ((wgid % nig) & 7), pn = (wgid % nig) >> 3;
        u.aoff[0][0] = 0u; u.aoff[0][1] = 0u; u.aoff[1][0] = 0u; u.aoff[1][1] = 0u;
        u.pn = pn; u.orow = pm * 256; u.aux = aux; u.Bb = Bt + (size_t)pn * 256 * DM * 2; u.Ab = A + (size_t)pm * 256 * DM * 2;
        return true;
    }
};
__device__ __forceinline__ void st_wt(h16* p, u32x4 v) { asm volatile("global_store_dwordx4 %0, %1, off sc0 sc1" :: "v"((GAS u32x4*)p), "v"(v) : "memory"); }
struct EpiInProj {
    static constexpr bool PERM = true, STORE_ONLY = true;
    h16 *Q, *K, *V, *P, *RB, *SPB;
    __device__ __forceinline__ bool operator()(g8::f32x4 (&acc)[2][2][4][2], const g8::Unit& u, int wr, int wc, int fr, int fq) const {
        const int pn = u.pn; const int row0 = u.orow + wr * 64 + fr;
        if (pn >= 8) {
            const int col0 = (pn - 8) * 128 + wc * 32 + 8 * fq;
#pragma unroll
            for (int ai = 0; ai < 2; ++ai)
#pragma unroll
                for (int m = 0; m < 4; ++m) { const size_t off = (size_t)(row0 + ai * 128 + m * 16) * DM + col0; float rr[8], sp[8];
#pragma unroll
                    for (int n = 0; n < 2; ++n)
#pragma unroll
                        for (int j = 0; j < 4; ++j) { const float es = __builtin_amdgcn_exp2f(acc[ai][0][m][n][j]), ep = __builtin_amdgcn_exp2f(acc[ai][1][m][n][j]);
                            const float ip = 1.f + ep; sp[4 * n + j] = __builtin_amdgcn_rcpf(ip); rr[4 * n + j] = __builtin_fminf(ip * __builtin_amdgcn_rcpf(1.f + es), 60000.f); }
                    u32x4 w, w2; w.x = pk_h2(rr[0], rr[1]); w.y = pk_h2(rr[2], rr[3]); w.z = pk_h2(rr[4], rr[5]); w.w = pk_h2(rr[6], rr[7]);
                    w2.x = pk_h2(sp[0], sp[1]); w2.y = pk_h2(sp[2], sp[3]); w2.z = pk_h2(sp[4], sp[5]); w2.w = pk_h2(sp[6], sp[7]);
                    if (u.aux & 2) { st_wt(RB + off, w); st_wt(SPB + off, w2); }
                    else { *(GAS u32x4*)(RB + off) = w; *(GAS u32x4*)(SPB + off) = w2; } }
            return false;
        }
        const int t = pn >> 1; h16* base = t == 0 ? Q : t == 1 ? K : t == 2 ? V : P;
        const int col0 = (pn & 1) * 256 + wc * 32 + 8 * fq;
        const bool headmajor = pn < 6;
#pragma unroll
        for (int ai = 0; ai < 2; ++ai)
#pragma unroll
            for (int m = 0; m < 4; ++m) { const int row = row0 + ai * 128 + m * 16;
                h16* rowp = headmajor ? base + ((size_t)((row / SEQ) * NH) * SEQ + (row % SEQ)) * HD + (size_t)(col0 >> 6) * SEQ * HD + (col0 & 63) : base + (size_t)row * PW + col0;
                const int bjstep = headmajor ? 2 * SEQ * HD : 128;
#pragma unroll
                for (int bj = 0; bj < 2; ++bj) { const g8::f32x4 v0 = acc[ai][bj][m][0], v1 = acc[ai][bj][m][1];
                    u32x4 w; w.x = pk_h2(v0[0], v0[1]); w.y = pk_h2(v0[2], v0[3]); w.z = pk_h2(v1[0], v1[1]); w.w = pk_h2(v1[2], v1[3]);
                    *(GAS u32x4*)(rowp + bj * bjstep) = w; } }
        return false;
    }
};
namespace att {
typedef short v4i16 __attribute__((ext_vector_type(4)));
__device__ __forceinline__ int crow(int r, int hi) { return (r & 3) + 8 * (r >> 2) + 4 * hi; }
__device__ __forceinline__ void swap32(float a, float b, float& r0, float& r1) {
    auto rr = __builtin_amdgcn_permlane32_swap(__float_as_uint(a), __float_as_uint(b), false, false);
    r0 = __uint_as_float(rr[0]); r1 = __uint_as_float(rr[1]);
}
template <bool DIAG>
__device__ __forceinline__ void tile_math(const f32x16& p, float& L, int r32, int hi, float hf, f16x8& pa0, f16x8& pa1) {
    float q[16], E[16];
#pragma unroll
    for (int r = 0; r < 16; ++r) {
        E[r] = __builtin_amdgcn_exp2f(__builtin_amdgcn_fmed3f(p[r], -1.0e30f, 100.f));
        q[r] = __builtin_amdgcn_rcpf(1.f + E[r]);
        if (DIAG) { if (!(crow(r, hi) < r32)) { q[r] = 1.f; E[r] = 0.f; } }
    }
    float G[4];
#pragma unroll
    for (int g = 0; g < 4; ++g) G[g] = (q[4 * g] * q[4 * g + 1]) * (q[4 * g + 2] * q[4 * g + 3]);
    float os[4]; os[3] = 1.f; os[2] = G[3]; os[1] = G[3] * G[2]; os[0] = os[1] * G[1];
    const float PL = __builtin_amdgcn_exp2f(L);
    float base[4];
#pragma unroll
    for (int g = 0; g < 4; ++g) { float r0, r1; swap32(hi ? os[g] * G[g] : os[g], os[g], r0, r1); base[g] = PL * (r0 * r1); }
    float tot; { const float t = os[0] * G[0]; float r0, r1; swap32(t, t, r0, r1); tot = r0 * r1; }
    float a[16];
#pragma unroll
    for (int g = 0; g < 4; ++g) {
        float ex = base[g];
#pragma unroll
        for (int k = 3; k >= 0; --k) { const int r = 4 * g + k; ex *= q[r]; a[r] = E[r] * ex; }
    }
    L += __builtin_amdgcn_logf(tot);
#pragma unroll
    for (int j = 0; j < 8; ++j) { pa0[j] = (_Float16)a[j]; pa1[j] = (_Float16)a[8 + j]; }
}
__device__ __forceinline__ f16x8 vtr2(const LAS unsigned char* p) {
    const v4i16 lo = __builtin_amdgcn_ds_read_tr16_b64_v4i16((LAS v4i16*)p);
    const v4i16 hi = __builtin_amdgcn_ds_read_tr16_b64_v4i16((LAS v4i16*)(p + 512));
    typedef short v8i16 __attribute__((ext_vector_type(8)));
    const v8i16 w = {lo[0], lo[1], lo[2], lo[3], hi[0], hi[1], hi[2], hi[3]};
    return __builtin_bit_cast(f16x8, w);
}
template <bool DIAG>
__device__ __forceinline__ bool attn_tile_lds(const LAS unsigned char* ks, const LAS unsigned char* vs, const f16x8 (&qf)[4], f32x16& o0, f32x16& o1, float& L, int ta, int r32, int hi, float hf) {
    f16x8 kf[4];
#pragma unroll
    for (int s = 0; s < 4; ++s) kf[s] = *(const LAS f16x8*)(ks + r32 * 128 + (((2 * s + hi) ^ (r32 & 7)) * 16));
    f32x16 p = {};
#pragma unroll
    for (int s = 0; s < 4; ++s) p = __builtin_amdgcn_mfma_f32_32x32x16_f16(kf[s], qf[s], p, 0, 0, 0);
    f16x8 pa0, pa1;
    tile_math<DIAG>(p, L, r32, hi, hf, pa0, pa1);
    const f16x8 v00 = vtr2(vs + ta), v01 = vtr2(vs + ta + 1024), v10 = vtr2(vs + ta + 2048), v11 = vtr2(vs + ta + 3072);
    o0 = __builtin_amdgcn_mfma_f32_32x32x16_f16(v00, pa0, o0, 0, 0, 0);
    o0 = __builtin_amdgcn_mfma_f32_32x32x16_f16(v01, pa1, o0, 0, 0, 0);
    o1 = __builtin_amdgcn_mfma_f32_32x32x16_f16(v10, pa0, o1, 0, 0, 0);
    o1 = __builtin_amdgcn_mfma_f32_32x32x16_f16(v11, pa1, o1, 0, 0, 0);
    return __all(L < EXIT_L2);
}
constexpr int ATT_WIN = 15, ATT_HIST = ATT_WIN - 8;
constexpr int ATT_KOFF = 0, ATT_VOFF = ATT_WIN * 4096, ATT_PRIV = 2 * ATT_WIN * 4096;
}
__device__ __forceinline__ void p2_attention_lds(Frame& F, h16* O) {
    using namespace att;
    const h16* Q = (const h16*)((F.a->ws) + WS_Q); const h16* K = (const h16*)((F.a->ws) + WS_K); const h16* V = (const h16*)((F.a->ws) + WS_V);
    const int lane = F.lane, r32 = lane & 31, hi = lane >> 5; const float hf = (float)hi;
    const int ta = (4 * hi + ((lane & 15) >> 2)) * 64 + ((lane >> 4) & 1) * 32 + (lane & 3) * 8;
    const int wa = ((lane & 7) >> 2) * 2048 + (lane >> 3) * 64 + (lane & 3) * 16;
    LAS unsigned char* priv = F.lds + ATT_PRIV + F.wave * 4096;
    const int t2 = F.tid & 255, skey = t2 >> 3, sc = t2 & 7; const bool isk = F.tid >= 256;
    const int sdst = isk ? ATT_KOFF + skey * 128 + ((sc ^ (skey & 7)) * 16) : ATT_VOFF + (sc >> 2) * 2048 + (skey >> 4) * 1024 + (skey & 15) * 64 + (sc & 3) * 16;
    u32x4 sv[ATT_WIN]; f16x8 qn[4];
#define ATT_LOAD_Q(R_) do { const int bh_ = (R_) >> 3, qb0_ = ((R_) & 7) * 8; const h16* qp_ = Q + (size_t)bh_ * SEQ * HD + (size_t)((qb0_ + F.wave) * 32 + r32) * HD + hi * 8; \
        _Pragma("unroll") for (int s = 0; s < 4; ++s) qn[s] = *(const GAS f16x8*)(qp_ + 16 * s); } while (0)
#define ATT_LOAD_FULL(R_) do { const int bh_ = (R_) >> 3, qb0_ = ((R_) & 7) * 8; const int jlo_ = qb0_ - ATT_HIST > 0 ? qb0_ - ATT_HIST : 0, ntile_ = qb0_ + 8 - jlo_; \
        const h16* src_ = (isk ? K : V) + (size_t)bh_ * SEQ * HD + (size_t)(32 * jlo_ + skey) * HD + sc * 8; \
        _Pragma("unroll") for (int t = 0; t < ATT_WIN; ++t) { const int tt = t < ntile_ ? t : ntile_ - 1; sv[t] = *(const GAS u32x4*)(src_ + (size_t)tt * 32 * HD); } } while (0)
#define ATT_LOAD_NEW(R_) do { const int bh_ = (R_) >> 3, qb0_ = ((R_) & 7) * 8; \
        const h16* src_ = (isk ? K : V) + (size_t)bh_ * SEQ * HD + (size_t)(32 * qb0_ + skey) * HD + sc * 8; \
        _Pragma("unroll") for (int t = 0; t < 8; ++t) sv[t] = *(const GAS u32x4*)(src_ + (size_t)t * 32 * HD); } while (0)
    const int NR = NB * NH * 8;
    for (int rd = F.vcu * 4; rd < NR; rd += F.G * 4) {
    ATT_LOAD_FULL(rd); ATT_LOAD_Q(rd);
    for (int rr = 0; rr < 4; ++rr) {
        const int R = rd + rr, bh = R >> 3, qb0 = (R & 7) * 8, b = bh >> 3, hh = bh & 7;
        const size_t hb = (size_t)bh * SEQ * HD; const size_t rowb = (size_t)b * SEQ;
        const int jlo = qb0 - ATT_HIST > 0 ? qb0 - ATT_HIST : 0;
        __syncthreads();
        if (rr == 0) { const int s0 = jlo % ATT_WIN;
#pragma unroll
            for (int t = 0; t < ATT_WIN; ++t) { int sl = s0 + t; sl = sl >= ATT_WIN ? sl - ATT_WIN : sl; *(LAS u32x4*)(F.lds + sdst + sl * 4096) = sv[t]; }
        } else { const int s0 = qb0 % ATT_WIN;
#pragma unroll
            for (int t = 0; t < 8; ++t) { int sl = s0 + t; sl = sl >= ATT_WIN ? sl - ATT_WIN : sl; *(LAS u32x4*)(F.lds + sdst + sl * 4096) = sv[t]; }
        }
        f16x8 qf[4];
#pragma unroll
        for (int s = 0; s < 4; ++s) qf[s] = qn[s];
        __syncthreads();
        { const int Rn = rr < 3 ? R + 1 : R; ATT_LOAD_NEW(Rn); ATT_LOAD_Q(Rn); }
        const int qb = qb0 + F.wave;

        f32x16 o0 = {}, o1 = {}; float L = 0.f;
        int j = qb, sl = qb % ATT_WIN;
        bool done = attn_tile_lds<true>(F.lds + ATT_KOFF + sl * 4096, F.lds + ATT_VOFF + sl * 4096, qf, o0, o1, L, ta, r32, hi, hf) || j == 0;
        --j; sl = sl == 0 ? ATT_WIN - 1 : sl - 1;
        while (!done && j >= jlo) { done = attn_tile_lds<false>(F.lds + ATT_KOFF + sl * 4096, F.lds + ATT_VOFF + sl * 4096, qf, o0, o1, L, ta, r32, hi, hf) || j == 0; --j; sl = sl == 0 ? ATT_WIN - 1 : sl - 1; }
        while (!done) {
            const h16* kp = K + hb + (size_t)(32 * j + r32) * HD + hi * 8; const h16* vp = V + hb + (size_t)(32 * j + (lane >> 3)) * HD + (lane & 7) * 8;
            f16x8 kf[4]; u32x4 vr[4];
#pragma unroll
            for (int s = 0; s < 4; ++s) kf[s] = *(const GAS f16x8*)(kp + 16 * s);
#pragma unroll
            for (int i = 0; i < 4; ++i) vr[i] = *(const GAS u32x4*)(vp + (size_t)(8 * i) * HD);
#pragma unroll
            for (int i = 0; i < 4; ++i) *(LAS u32x4*)(priv + wa + (i >> 1) * 1024 + (i & 1) * 512) = vr[i];
            f32x16 p = {};
#pragma unroll
            for (int s = 0; s < 4; ++s) p = __builtin_amdgcn_mfma_f32_32x32x16_f16(kf[s], qf[s], p, 0, 0, 0);
            f16x8 pa0, pa1;
            tile_math<false>(p, L, r32, hi, hf, pa0, pa1);
            asm volatile("" ::: "memory");
            const f16x8 v00 = vtr2(priv + ta), v01 = vtr2(priv + ta + 1024), v10 = vtr2(priv + ta + 2048), v11 = vtr2(priv + ta + 3072);
            o0 = __builtin_amdgcn_mfma_f32_32x32x16_f16(v00, pa0, o0, 0, 0, 0);
            o0 = __builtin_amdgcn_mfma_f32_32x32x16_f16(v01, pa1, o0, 0, 0, 0);
            o1 = __builtin_amdgcn_mfma_f32_32x32x16_f16(v10, pa0, o1, 0, 0, 0);
            o1 = __builtin_amdgcn_mfma_f32_32x32x16_f16(v11, pa1, o1, 0, 0, 0);
            asm volatile("" ::: "memory");
            done = __all(L < EXIT_L2) || j == 0; --j;
        }
        h16* op = O + (rowb + qb * 32 + r32) * DM + hh * HD + 4 * hi;
#pragma unroll
        for (int g = 0; g < 4; ++g) {
            u32x2 w0, w1; w0.x = pk_h2(o0[4 * g], o0[4 * g + 1]); w0.y = pk_h2(o0[4 * g + 2], o0[4 * g + 3]); w1.x = pk_h2(o1[4 * g], o1[4 * g + 1]); w1.y = pk_h2(o1[4 * g + 2], o1[4 * g + 3]);
            *(GAS u32x2*)(op + 8 * g) = w0; *(GAS u32x2*)(op + 32 + 8 * g) = w1;
        }
    }
    }
#undef ATT_LOAD_Q
#undef ATT_LOAD_FULL
#undef ATT_LOAD_NEW
    __syncthreads();
}
template <int W> __device__ __forceinline__ void pool_win_load(const h16* P, int row_first, int ch, u32x4 (&x)[W + 3]) {
    const int t_first = row_first & (SEQ - 1);
#pragma unroll
    for (int i = 0; i < W + 3; ++i) { const int back = (W - 1) - i;
        const int bk = back <= t_first ? back : t_first;
        x[i] = *(const GAS u32x4*)(P + (size_t)(row_first - bk) * PW + ch * 8); }
}
template <int W> __device__ __forceinline__ void pool_win_store(h16* PO, int row_first, int ch, u32x4 (&x)[W + 3]) {
    const int t_first = row_first & (SEQ - 1);
    float s[8];
#pragma unroll
    for (int e = 0; e < 8; ++e) s[e] = 0.f;
#pragma unroll
    for (int i = 0; i < W + 3; ++i) { const int back = (W - 1) - i; if (back > t_first) x[i] = (u32x4){0u, 0u, 0u, 0u}; }
#pragma unroll
    for (int i = 0; i < W; ++i) { const f16x8 v = __builtin_bit_cast(f16x8, x[i]);
#pragma unroll
        for (int e = 0; e < 8; ++e) s[e] += (float)v[e]; }
#pragma unroll
    for (int j = 0; j < 4; ++j) {
        const f16x8 cur = __builtin_bit_cast(f16x8, x[W - 1 + j]);
        if (j > 0) { const f16x8 drop = __builtin_bit_cast(f16x8, x[j - 1]);
#pragma unroll
            for (int e = 0; e < 8; ++e) s[e] += (float)cur[e] - (float)drop[e]; }
        const int t = t_first + j; const float inv = 1.f / (float)((t + 1) < W ? (t + 1) : W);
        u32x4 o; o.x = pk_h2(s[0] * inv - (float)cur[0], s[1] * inv - (float)cur[1]); o.y = pk_h2(s[2] * inv - (float)cur[2], s[3] * inv - (float)cur[3]);
        o.z = pk_h2(s[4] * inv - (float)cur[4], s[5] * inv - (float)cur[5]); o.w = pk_h2(s[6] * inv - (float)cur[6], s[7] * inv - (float)cur[7]);
        *(GAS u32x4*)(PO + (size_t)(row_first + j) * DM + PW + ch * 8) = o;
    }
}
__device__ __forceinline__ void p2_pool(Frame& F) {
    const h16* P = (const h16*)((F.a->ws) + WS_P); h16* PO = (h16*)((F.a->ws) + WS_CAT);
    const int gw = F.vcu * NWAVES + F.wave, NGW = F.G * NWAVES;
    for (int it = gw; it < M / 16; it += NGW) {
        const int row_first = it * 16 + 4 * (F.lane >> 4), c16 = F.lane & 15;
        { u32x4 x3[19]; pool_win_load<16>(P, row_first, 48 + c16, x3); pool_win_store<16>(PO, row_first, 48 + c16, x3); }
        { u32x4 x0[5], x1[7], x2[11];
          pool_win_load<2>(P, row_first, c16, x0); pool_win_load<4>(P, row_first, 16 + c16, x1); pool_win_load<8>(P, row_first, 32 + c16, x2);
          pool_win_store<2>(PO, row_first, c16, x0); pool_win_store<4>(PO, row_first, 16 + c16, x1); pool_win_store<8>(PO, row_first, 32 + c16, x2); }
    }
}
struct EpiBranchFused {
    static constexpr bool PERM = true, STORE_ONLY = false;
    h16* MG; const h16* RB; const h16* SPB;
    __device__ __forceinline__ bool operator()(g8::f32x4 (&acc)[2][2][4][2], const g8::Unit& u, int wr, int wc, int fr, int fq) const {
        const int row0 = u.orow + wr * 64 + fr, col0 = u.pn * 256 + wc * 32 + 8 * fq;
        if (u.aux == 0) {
            f16x8 rv[2][4][2];
#pragma unroll
            for (int ai = 0; ai < 2; ++ai)
#pragma unroll
                for (int m = 0; m < 4; ++m)
#pragma unroll
                    for (int bj = 0; bj < 2; ++bj) rv[ai][m][bj] = *(const GAS f16x8*)(RB + (size_t)(row0 + ai * 128 + m * 16) * DM + col0 + bj * 128);
#pragma unroll
            for (int ai = 0; ai < 2; ++ai)
#pragma unroll
                for (int m = 0; m < 4; ++m)
#pragma unroll
                    for (int bj = 0; bj < 2; ++bj)
#pragma unroll
                        for (int j = 0; j < 4; ++j) { acc[ai][bj][m][0][j] *= (float)rv[ai][m][bj][j]; acc[ai][bj][m][1][j] *= (float)rv[ai][m][bj][4 + j]; }
            return true;
        }
        f16x8 sgv[2][4][2];
#pragma unroll
        for (int ai = 0; ai < 2; ++ai)
#pragma unroll
            for (int m = 0; m < 4; ++m)
#pragma unroll
                for (int bj = 0; bj < 2; ++bj) sgv[ai][m][bj] = *(const GAS f16x8*)(SPB + (size_t)(row0 + ai * 128 + m * 16) * DM + col0 + bj * 128);
#pragma unroll
        for (int ai = 0; ai < 2; ++ai)
#pragma unroll
            for (int m = 0; m < 4; ++m) { const size_t off = (size_t)(row0 + ai * 128 + m * 16) * DM + col0;
#pragma unroll
                for (int bj = 0; bj < 2; ++bj) { const g8::f32x4 v0 = acc[ai][bj][m][0], v1 = acc[ai][bj][m][1];
                    const f16x8 sg = sgv[ai][m][bj];
                    u32x4 w; w.x = pk_h2((float)sg[0] * v0[0], (float)sg[1] * v0[1]); w.y = pk_h2((float)sg[2] * v0[2], (float)sg[3] * v0[3]);
                    w.z = pk_h2((float)sg[4] * v1[0], (float)sg[5] * v1[1]); w.w = pk_h2((float)sg[6] * v1[2], (float)sg[7] * v1[3]);
                    *(GAS u32x4*)(MG + off + bj * 128) = w; } }
        return false;
    }
};
struct EpiOutProj {
    static constexpr bool PERM = true, STORE_ONLY = false;
    const float* x; const float* mods; h16* x1;
    __device__ __forceinline__ bool operator()(g8::f32x4 (&acc)[2][2][4][2], const g8::Unit& u, int wr, int wc, int fr, int fq) const {
        const int row0 = u.orow + wr * 64 + fr, col0 = u.pn * 256 + wc * 32 + 8 * fq; const float* gt = mods + (u.orow / SEQ) * NMODS + 2048;
        g8::f32x4 gv[2][2];
#pragma unroll
        for (int bj = 0; bj < 2; ++bj)
#pragma unroll
            for (int n = 0; n < 2; ++n) gv[bj][n] = *(const GAS g8::f32x4*)(gt + col0 + bj * 128 + n * 4);
#pragma unroll
        for (int ai = 0; ai < 2; ++ai) {
            g8::f32x4 xv[4][2][2];
#pragma unroll
            for (int m = 0; m < 4; ++m)
#pragma unroll
                for (int bj = 0; bj < 2; ++bj)
#pragma unroll
                    for (int n = 0; n < 2; ++n) xv[m][bj][n] = __builtin_nontemporal_load((const GAS g8::f32x4*)(x + (size_t)(row0 + ai * 128 + m * 16) * DM + col0 + bj * 128 + n * 4));
#pragma unroll
            for (int m = 0; m < 4; ++m) { const size_t off = (size_t)(row0 + ai * 128 + m * 16) * DM + col0;
#pragma unroll
                for (int bj = 0; bj < 2; ++bj) {
                    const g8::f32x4 r0 = xv[m][bj][0] + gv[bj][0] * acc[ai][bj][m][0], r1 = xv[m][bj][1] + gv[bj][1] * acc[ai][bj][m][1];
                    u32x4 w; w.x = pk_h2(r0[0], r0[1]); w.y = pk_h2(r0[2], r0[3]); w.z = pk_h2(r1[0], r1[1]); w.w = pk_h2(r1[2], r1[3]);
                    *(GAS u32x4*)(x1 + off + bj * 128) = w; } }
            asm volatile("" ::: "memory");
        }
        return false;
    }
};
constexpr int MISC_LCNT = 16, MISC_GBASE = 48;
constexpr int RT_WR_OFF = 32768, RT_WR_PITCH = 2064;
__device__ __forceinline__ void p5_route(Frame& F) {
    const float* mods = (const float*)((F.a->ws) + WS_MODS); h16* H2 = (h16*)((F.a->ws) + WS_RA); const h16* WR = (const h16*)((F.a->ws) + WS_WR);
    int* eid = (int*)((F.a->ws) + WS_EID); float* cw = (float*)((F.a->ws) + WS_CW); int* pos = (int*)((F.a->ws) + WS_POS); int* list = (int*)((F.a->ws) + WS_LIST);
    int* lcnt = (int*)(F.lds + MISC_OFF) + MISC_LCNT; int* gbase = (int*)(F.lds + MISC_OFF) + MISC_GBASE;
    float* lgs = (float*)(F.lds + F.wave * 4096);
    const int fr = F.lane & 15, fq = F.lane >> 4;
    {
        u32x4 wv[12];
#pragma unroll
        for (int i = 0; i < 12; ++i) { const int p = F.tid + i * 512; wv[i] = *(const GAS u32x4*)(WR + (size_t)(p >> 7) * DM + (p & 127) * 8); }
#pragma unroll
        for (int i = 0; i < 12; ++i) { const int p = F.tid + i * 512; *(LAS u32x4*)(F.lds + RT_WR_OFF + (p >> 7) * RT_WR_PITCH + (p & 127) * 16) = wv[i]; }
    }
    for (int chunk = F.vcu; chunk < M / 128; chunk += F.G) {
        const int row0 = chunk * 128 + F.wave * 16;
        if (F.tid < 32) lcnt[F.tid] = 0;
        __syncthreads();
        {
            const float* mb = mods + (row0 / SEQ) * NMODS; float ca[16], cb[16];
#pragma unroll
            for (int h = 0; h < 2; ++h)
#pragma unroll
                for (int q = 0; q < 2; ++q) { const int idx = h * 512 + F.lane * 8 + q * 4;
                    const f32x4 gg = *(const GAS f32x4*)((F.a->in[3]) + idx), sc = *(const GAS f32x4*)(mb + 4096 + idx), sh = *(const GAS f32x4*)(mb + 3072 + idx);
#pragma unroll
                    for (int j = 0; j < 4; ++j) { ca[h * 8 + q * 4 + j] = gg[j] * (1.f + sc[j]); cb[h * 8 + q * 4 + j] = sh[j]; } }
            const h16* X1 = (const h16*)((F.a->ws) + WS_X1);
            f16x8 xv[16][2];
#pragma unroll
            for (int rr = 0; rr < 16; ++rr)
#pragma unroll
                for (int h = 0; h < 2; ++h) xv[rr][h] = *(const GAS f16x8*)(X1 + (size_t)(row0 + rr) * DM + h * 512 + F.lane * 8);
#pragma unroll
            for (int rr = 0; rr < 16; ++rr) {
                float xf[16]; float ss = 0.f;
#pragma unroll
                for (int j = 0; j < 16; ++j) { xf[j] = (float)xv[rr][j >> 3][j & 7]; ss += xf[j] * xf[j]; }
                ss = wave_sum(ss);
                const float rs = 1.0f / sqrtf(ss * (1.0f / DM) + EPS);
#pragma unroll
                for (int h = 0; h < 2; ++h) { u32x4 o;
                    o.x = pk_h2(xf[8 * h] * rs * ca[8 * h] + cb[8 * h], xf[8 * h + 1] * rs * ca[8 * h + 1] + cb[8 * h + 1]); o.y = pk_h2(xf[8 * h + 2] * rs * ca[8 * h + 2] + cb[8 * h + 2], xf[8 * h + 3] * rs * ca[8 * h + 3] + cb[8 * h + 3]);
                    o.z = pk_h2(xf[8 * h + 4] * rs * ca[8 * h + 4] + cb[8 * h + 4], xf[8 * h + 5] * rs * ca[8 * h + 5] + cb[8 * h + 5]); o.w = pk_h2(xf[8 * h + 6] * rs * ca[8 * h + 6] + cb[8 * h + 6], xf[8 * h + 7] * rs * ca[8 * h + 7] + cb[8 * h + 7]);
                    *(GAS u32x4*)(H2 + (size_t)(row0 + rr) * DM + h * 512 + F.lane * 8) = o; }
            }
        }
        VM_WAIT();
        g8::f32x4 acc[3];
#pragma unroll
        for (int nf = 0; nf < 3; ++nf) acc[nf] = (g8::f32x4){0.f, 0.f, 0.f, 0.f};
        {
            const h16* ap = H2 + (size_t)(row0 + fr) * DM + fq * 8; const LAS unsigned char* bp = F.lds + RT_WR_OFF + fr * RT_WR_PITCH + fq * 16;
            f16x8 av[32];
#pragma unroll
            for (int kb = 0; kb < 32; ++kb) av[kb] = *(const GAS f16x8*)(ap + 32 * kb);
#pragma unroll
            for (int kb = 0; kb < 32; ++kb)
#pragma unroll
                for (int nf = 0; nf < 3; ++nf) { const f16x8 bf = *(const LAS f16x8*)(bp + (16 * nf) * RT_WR_PITCH + 64 * kb); acc[nf] = __builtin_amdgcn_mfma_f32_16x16x32_f16(av[kb], bf, acc[nf], 0, 0, 0); }
        }
#pragma unroll
        for (int nf = 0; nf < 3; ++nf)
#pragma unroll
            for (int rg = 0; rg < 4; ++rg) lgs[(4 * fq + rg) * 49 + 16 * nf + fr] = acc[nf][rg];
        LDS_WAIT(); asm volatile("" ::: "memory");
        const float* lr = lgs + fr * 49;
        float gl[4];
#pragma unroll
        for (int j = 0; j < 4; ++j) gl[j] = lr[j] + (F.a->in[13])[j];
        int gsel = 0; float gm = gl[0];
#pragma unroll
        for (int j = 1; j < 4; ++j) if (gl[j] > gm) { gm = gl[j]; gsel = j; }
        float den = 0.f;
#pragma unroll
        for (int j = 0; j < 4; ++j) den += expf(gl[j] - gm);
        const float pg = 1.f / den;
        float el[8];
#pragma unroll
        for (int e = 0; e < 8; ++e) el[e] = lr[4 + gsel * 8 + e] + (F.a->in[15])[gsel * 8 + e];
        int i0 = 0; float v0 = el[0];
#pragma unroll
        for (int e = 1; e < 8; ++e) if (el[e] > v0) { v0 = el[e]; i0 = e; }
        int i1 = 0; float v1 = -3.0e38f;
#pragma unroll
        for (int e = 0; e < 8; ++e) if (e != i0 && el[e] > v1) { v1 = el[e]; i1 = e; }
        const float w0 = 1.f / (1.f + expf(v1 - v0)), w1 = 1.f - w0;
        const int e0 = gsel * 8 + i0, e1 = gsel * 8 + i1;
        int lp0 = 0, lp1 = 0;
        if (F.lane < 16) { lp0 = __hip_atomic_fetch_add(lcnt + e0, 1, __ATOMIC_RELAXED, __HIP_MEMORY_SCOPE_WORKGROUP); lp1 = __hip_atomic_fetch_add(lcnt + e1, 1, __ATOMIC_RELAXED, __HIP_MEMORY_SCOPE_WORKGROUP); }
        __syncthreads();
        if (F.tid < 32) gbase[F.tid] = (int)__hip_atomic_fetch_add((unsigned*)(F.ctl + CW_GCNT + 64 * F.tid), (unsigned)lcnt[F.tid], RLX_AGENT);
        __syncthreads();
        if (F.lane < 16) { const int row = row0 + fr; const int p0 = gbase[e0] + lp0, p1 = gbase[e1] + lp1;
            list[e0 * LISTCAP + p0] = row; list[e1 * LISTCAP + p1] = row;
            eid[2 * row] = e0; eid[2 * row + 1] = e1; cw[2 * row] = pg * w0; cw[2 * row + 1] = pg * w1; pos[2 * row] = p0; pos[2 * row + 1] = p1; }
        __syncthreads();
    }
}
struct ExpertTiles {
    int cnt_l, tb_l, T;
    __device__ __forceinline__ void init(gu32* ctl, int lane) {
        const int cnt = lane < 32 ? (int)__hip_atomic_load(ctl + CW_GCNT + 64 * (lane & 31), RLX_AGENT) : 0;
        const int tiles = (cnt + 255) >> 8; int incl = tiles;
#pragma unroll
        for (int o = 1; o < 32; o <<= 1) { const int t = __shfl_up(incl, o); if ((lane & 31) >= o) incl += t; }
        cnt_l = cnt; tb_l = incl - tiles; T = __shfl(incl, 31);
    }
};
constexpr int MISC_ECNT = 80, MISC_ETB = 112, MISC_ET = 144, MISC_NFK = 145, MISC_NSP = 146, MISC_ETP = 147, MISC_EFB = 160, MISC_EHB = 192, MISC_EHALF = 224;
__device__ __forceinline__ void moe_table_to_lds(Frame& F) {
    if (F.wave == 0) { ExpertTiles et; et.init(F.ctl, F.lane); int* mi = (int*)(F.lds + MISC_OFF);
        const int l = F.lane & 31; const int tiles = (et.cnt_l + 255) >> 8; const int half = (F.lane < 32 && tiles >= 1 && (et.cnt_l - 256 * (tiles - 1)) <= 128) ? 1 : 0; const int full = (F.lane < 32 ? tiles : 0) - half;
        int fi = full, hi2 = half;
#pragma unroll
        for (int o = 1; o < 32; o <<= 1) { const int a = __shfl_up(fi, o), b = __shfl_up(hi2, o); if (l >= o) { fi += a; hi2 += b; } }
        if (F.lane < 32) { mi[MISC_ECNT + l] = et.cnt_l; mi[MISC_ETB + l] = et.tb_l; mi[MISC_EFB + l] = fi - full; mi[MISC_EHB + l] = hi2 - half; mi[MISC_EHALF + l] = half; }
        if (F.lane == 31) { const int NF = fi, NH = hi2, G = F.G; const int total = 4 * (NF + NH); const int done = total > 0 ? ((total - 1) / G) * G : 0;
            int FL = 4 * NF - done; FL = FL > 0 ? (FL + 3) >> 2 : 0;
            if (4 * (2 * FL + NH) > G) FL = 0;
            mi[MISC_NFK] = NF - FL; mi[MISC_NSP] = 2 * FL; mi[MISC_ETP] = NF + FL + NH; }
        if (F.lane == 0) mi[MISC_ET] = et.T; }
    __syncthreads();
}
__device__ __forceinline__ void moe_unit_lookup(const int* mi, int idx, int lane, int& e, int& rt, int& half, int& sh) {
    const int NFK = mi[MISC_NFK], NSP = mi[MISC_NSP];
    if (idx < NFK + NSP) { const int ft = idx < NFK ? idx : NFK + ((idx - NFK) >> 1); half = idx < NFK ? 0 : 1; sh = idx < NFK ? 0 : ((idx - NFK) & 1) * 128;
        const unsigned long long mk = __ballot(lane < 32 && mi[MISC_EFB + (lane & 31)] <= ft);
        e = __builtin_amdgcn_readfirstlane(__builtin_popcountll(mk) - 1); rt = __builtin_amdgcn_readfirstlane(mi[MISC_ETB + e] + (ft - mi[MISC_EFB + e])); }
    else { const int k = idx - NFK - NSP; const unsigned long long mk = __ballot(lane < 32 && mi[MISC_EHALF + (lane & 31)] != 0 && mi[MISC_EHB + (lane & 31)] == k);
        e = __builtin_amdgcn_readfirstlane((int)__builtin_ctzll(mk | (1ull << 31))); const int cn = mi[MISC_ECNT + e];
        rt = __builtin_amdgcn_readfirstlane(mi[MISC_ETB + e] + ((cn + 255) >> 8) - 1); half = 1; sh = 0; }
}
template <bool DOWN> struct MoeSched {
    static constexpr bool GATHER = true, HALFABLE = true;
    int G, c, tid; const char* Wb; const int* list; const int* mi;
    __device__ __forceinline__ void init(const unsigned char* lds_generic, const void* Wb_, const int* list_, int G_, int c_, int tid_) { tid = tid_; G = G_; c = c_; Wb = (const char*)Wb_; list = list_; mi = (const int*)(lds_generic + MISC_OFF); }
    __device__ __forceinline__ bool next(int i, g8::Unit& u) const {
        const int units = mi[MISC_ETP] * 4; int L = i * G + c;
        if ((i + 1) * G > units && (G & 31) == 0) { const int per = G >> 3, j = c % per, x = c / per; L = i * G + ((((j >> 2) * 8 + x) << 2) | (j & 3)); }
        if (L >= units) return false;
        const int pn = L & 3, lane = tid & 63; int e, rt, half, sh;
        moe_unit_lookup(mi, L >> 2, lane, e, rt, half, sh);
        const int tb = __builtin_amdgcn_readfirstlane(mi[MISC_ETB + e]), cn = __builtin_amdgcn_readfirstlane(mi[MISC_ECNT + e]);
        u.pn = pn; u.orow = rt * 256 + sh; u.aux = e | (half << 8); u.Ab = nullptr;
        int R[2], C[2];
#pragma unroll
        for (int i2 = 0; i2 < 2; ++i2) g8::stage_rc(tid * 16 + i2 * 8192, R[i2], C[i2]);
        if (DOWN) { u.Bb = Wb + (size_t)e * (DM * DE * 2) + (size_t)pn * 256 * DE * 2;
#pragma unroll
            for (int h = 0; h < 2; ++h)
#pragma unroll
                for (int i2 = 0; i2 < 2; ++i2) u.aoff[h][i2] = (unsigned)((u.orow + (half ? 0 : h * 128) + R[i2]) * DE + C[i2]) * 2u;
        } else { u.Bb = Wb + (size_t)e * (DM * DM * 2) + (size_t)pn * 256 * DM * 2; const int trow = (rt - tb) * 256 + sh;
#pragma unroll
            for (int h = 0; h < 2; ++h)
#pragma unroll
                for (int i2 = 0; i2 < 2; ++i2) { int r = trow + (half ? 0 : h * 128) + R[i2]; r = r < cn ? r : cn - 1; const int tok = list[e * LISTCAP + r]; u.aoff[h][i2] = (unsigned)(tok * DM + C[i2]) * 2u; }
        }
        return true;
    }
};
struct EpiMoeUp {
    static constexpr bool PERM = true, STORE_ONLY = true;
    h16* H;
    __device__ __forceinline__ bool operator()(g8::f32x4 (&acc)[2][2][4][2], const g8::Unit& u, int wr, int wc, int fr, int fq) const {
        const int row0 = u.orow + wr * 64 + fr, col0 = u.pn * 128 + wc * 32 + 8 * fq;
#pragma unroll
        for (int ai = 0; ai < 2; ++ai) { if (ai == 1 && (u.aux & 256)) break;
#pragma unroll
            for (int m = 0; m < 4; ++m) { float r[8];
#pragma unroll
                for (int n = 0; n < 2; ++n)
#pragma unroll
                    for (int j = 0; j < 4; ++j) { const float g = acc[ai][0][m][n][j], up = acc[ai][1][m][n][j]; r[4 * n + j] = g * fast_sigmoid(g) * up; }
                u32x4 w; w.x = pk_h2(r[0], r[1]); w.y = pk_h2(r[2], r[3]); w.z = pk_h2(r[4], r[5]); w.w = pk_h2(r[6], r[7]);
                *(GAS u32x4*)(H + (size_t)(row0 + ai * 128 + m * 16) * DE + col0) = w; } }
        return false;
    }
};
struct EpiMoeDown {
    static constexpr bool PERM = true, STORE_ONLY = true;
    h16* Y;
    __device__ __forceinline__ bool operator()(g8::f32x4 (&acc)[2][2][4][2], const g8::Unit& u, int wr, int wc, int fr, int fq) const {
        const int row0 = u.orow + wr * 64 + fr, col0 = u.pn * 256 + wc * 32 + 8 * fq;
#pragma unroll
        for (int ai = 0; ai < 2; ++ai) { if (ai == 1 && (u.aux & 256)) break;
#pragma unroll
            for (int m = 0; m < 4; ++m) { h16* rowp = Y + (size_t)(row0 + ai * 128 + m * 16) * DM + col0;
#pragma unroll
                for (int bj = 0; bj < 2; ++bj) { const g8::f32x4 v0 = acc[ai][bj][m][0], v1 = acc[ai][bj][m][1];
                    u32x4 w; w.x = pk_h2(v0[0], v0[1]); w.y = pk_h2(v0[2], v0[3]); w.z = pk_h2(v1[0], v1[1]); w.w = pk_h2(v1[2], v1[3]);
                    *(GAS u32x4*)(rowp + bj * 128) = w; } } }
        return false;
    }
};
__device__ __forceinline__ void p8_final(Frame& F, float* dst) {
    ExpertTiles et; et.init(F.ctl, F.lane);
    const float* mods = (const float*)((F.a->ws) + WS_MODS); const h16* Y = (const h16*)((F.a->ws) + WS_Y); const h16* X1 = (const h16*)((F.a->ws) + WS_X1);
    const int* eid = (const int*)((F.a->ws) + WS_EID); const float* cw = (const float*)((F.a->ws) + WS_CW); const int* pos = (const int*)((F.a->ws) + WS_POS);
    const int gw = F.vcu * NWAVES + F.wave, NGW = F.G * NWAVES;
    for (int m0 = gw * 16; m0 < M; m0 += NGW * 16) {
        const int ea = eid[2 * m0 + (F.lane & 31)], pa = pos[2 * m0 + (F.lane & 31)]; const float wa = cw[2 * m0 + (F.lane & 31)];
        const int slot = __shfl(et.tb_l, ea) * 256 + pa;
        const float* g2 = mods + (m0 / SEQ) * NMODS + 5120; float cg[16], cf[16];
#pragma unroll
        for (int h = 0; h < 2; ++h)
#pragma unroll
            for (int q = 0; q < 2; ++q) { const int idx = h * 512 + F.lane * 8 + q * 4; const f32x4 a = *(const GAS f32x4*)(g2 + idx), b = *(const GAS f32x4*)((F.a->in[19]) + idx);
#pragma unroll
                for (int j = 0; j < 4; ++j) { cg[h * 8 + q * 4 + j] = a[j]; cf[h * 8 + q * 4 + j] = b[j]; } }
#pragma unroll 1
        for (int r4 = 0; r4 < 16; r4 += 4) {
            f16x8 xv[4][2], ya[4][2], yb[4][2]; float c0[4], c1[4];
#pragma unroll
            for (int rr = 0; rr < 4; ++rr) { const int r = r4 + rr; const int s0 = __shfl(slot, 2 * r), s1 = __shfl(slot, 2 * r + 1); c0[rr] = __shfl(wa, 2 * r); c1[rr] = __shfl(wa, 2 * r + 1);
#pragma unroll
                for (int h = 0; h < 2; ++h) { xv[rr][h] = __builtin_nontemporal_load((const GAS f16x8*)(X1 + (size_t)(m0 + r) * DM + h * 512 + F.lane * 8));
                    ya[rr][h] = __builtin_nontemporal_load((const GAS f16x8*)(Y + (size_t)s0 * DM + h * 512 + F.lane * 8)); yb[rr][h] = __builtin_nontemporal_load((const GAS f16x8*)(Y + (size_t)s1 * DM + h * 512 + F.lane * 8)); } }
#pragma unroll
            for (int rr = 0; rr < 4; ++rr) {
                float t[16]; float ss = 0.f;
#pragma unroll
                for (int j = 0; j < 16; ++j) { t[j] = (float)xv[rr][j >> 3][j & 7] + cg[j] * (c0[rr] * (float)ya[rr][j >> 3][j & 7] + c1[rr] * (float)yb[rr][j >> 3][j & 7]); ss += t[j] * t[j]; }
                ss = wave_sum(ss);
                const float rs = 1.0f / sqrtf(ss * (1.0f / DM) + EPS);
                float* orow = dst + (size_t)(m0 + r4 + rr) * DM;
#pragma unroll
                for (int h = 0; h < 2; ++h)
#pragma unroll
                    for (int q = 0; q < 2; ++q) { f32x4 o;
#pragma unroll
                        for (int j = 0; j < 4; ++j) o[j] = t[h * 8 + q * 4 + j] * rs * cf[h * 8 + q * 4 + j];
                        *(GAS f32x4*)(orow + h * 512 + F.lane * 8 + q * 4) = o; }
            }
        }
    }
}
__global__ void __launch_bounds__(NWAVES * 64, 2) mk_fwd(Args args) {
    extern __shared__ __attribute__((aligned(16))) unsigned char lds[];
    Frame F;
    F.lds = (LAS unsigned char*)lds;
    F.MISC = (volatile LAS unsigned*)(F.lds + MISC_OFF);
    F.tid = threadIdx.x; F.lane = F.tid & 63; F.wave = __builtin_amdgcn_readfirstlane(F.tid >> 6);
    F.G = gridDim.x; { const int bx = blockIdx.x; F.vcu = (F.G % 8 == 0) ? (bx % 8) * (F.G / 8) + bx / 8 : bx; }
    F.a = &args; F.ctl = (gu32*)(args.ws + WS_CTL);
    if (F.G == 256) { const bool cv = (F.vcu % 9) == 8; F.nconv = 28; F.conv_rank = cv ? F.vcu / 9 : -1;
        const int xcd = F.vcu >> 5, first = xcd << 5, j = (F.vcu - first) - (F.vcu / 9 - first / 9), label = (xcd & 1) ? 4 + (xcd >> 1) : (xcd >> 1);
        F.gemm_rank = label + 8 * j; }
    else { F.nconv = 0; F.conv_rank = -1; F.gemm_rank = F.vcu; }
    for (int u = F.tid; u < 256; u += NWAVES * 64) F.MISC[u] = 0u;
    __syncthreads();
    XcdBarrier bar = xcd_barrier_post((unsigned*)(F.ctl + CW_BAR), F.MISC + 8);
    if (F.tid == 0) { const unsigned me = bar.x + 1u; const unsigned prev = atomicCAS((unsigned*)(F.ctl + CW_GRPX + 8 * ((F.vcu >> 5) & 7)), 0u, me);
        if ((prev != 0u && prev != me) || F.G != 256) __hip_atomic_store((unsigned*)(F.ctl + CW_NONLOCAL), 1u, RLX_AGENT); }
    bool local_ok = false;
    const int lo = args.ph_lo, hi = args.ph_hi;
#define IN(k) (lo <= (k) && (k) < hi)
#define BOTH(k) (IN(k) && IN((k) + 1))
#define GRID_BAR() xcd_barrier(bar)
#define SEAM_BAR() do { if (local_ok) xcd_barrier_local(bar); else xcd_barrier(bar); } while (0)
    if (IN(0)) { p0_prologue(F); }
    if (IN(1)) { wait_mods(F); p1a_rows(F); if (BOTH(1)) { GRID_BAR(); local_ok = __hip_atomic_load((unsigned*)(F.ctl + CW_NONLOCAL), RLX_AGENT) == 0u; } }
    if (IN(2)) {
        if (F.conv_rank >= 0) p0_convert_experts(F, F.conv_rank * NWAVES + F.wave, F.nconv * NWAVES, 0, I_CONV);
        else {
            EpiInProj E{(h16*)((F.a->ws) + WS_Q), (h16*)((F.a->ws) + WS_K), (h16*)((F.a->ws) + WS_V), (h16*)((F.a->ws) + WS_P), (h16*)((F.a->ws) + WS_SGS), (h16*)((F.a->ws) + WS_SGP)};
            if (F.G == 256) { InProjSched S; S.init((F.a->ws) + WS_RA, (F.a->ws) + WS_WIN, F.vcu >> 5, F.gemm_rank >> 3); g8::gemm_phase(F.lds, (const char*)((F.a->ws) + WS_RA), DM, DM, S, E); }
            else { DenseSched S; S.init(M, NPROJ, DM, DM, 1, (F.a->ws) + WS_RA, (F.a->ws) + WS_WIN, F.G - F.nconv, F.gemm_rank); g8::gemm_phase(F.lds, (const char*)((F.a->ws) + WS_RA), DM, DM, S, E); }
        }
        if (BOTH(2)) SEAM_BAR();
    }
    if (IN(3)) { p2_attention_lds(F, (h16*)((F.a->ws) + WS_CAT)); p2_pool(F);
        if (BOTH(3)) {
            if (local_ok) { unsigned* ww = nullptr; const int g = F.vcu >> 5;
                if (g & 1) { const unsigned nbx = __hip_atomic_load((unsigned*)(F.ctl + CW_GRPX + 8 * (g - 1)), RLX_AGENT) - 1u; ww = bar.bar + XB_XGEN(nbx & 15u); }
                xcd_barrier_local(bar, ww, 2u); }
            else GRID_BAR(); } }
    if (IN(4)) {
        DenseSchedT<2> S; S.init(M, DM, PW, DM, 2, (F.a->ws) + WS_CAT, (F.a->ws) + WS_WCAT, F.G, (int)blockIdx.x); EpiBranchFused E{(h16*)((F.a->ws) + WS_RA), (const h16*)((F.a->ws) + WS_SGS), (const h16*)((F.a->ws) + WS_SGP)};
        g8::gemm_phase(F.lds, (const char*)((F.a->ws) + WS_CAT), PW, DM, S, E);
        if (BOTH(4)) SEAM_BAR();
    }
    if (IN(5)) {
        DenseSched S; S.init(M, DM, DM, DM, 1, (F.a->ws) + WS_RA, (F.a->ws) + WS_WOUT, F.G, (int)blockIdx.x); EpiOutProj E{(F.a->in[0]), (const float*)((F.a->ws) + WS_MODS), (h16*)((F.a->ws) + WS_X1)};
        g8::gemm_phase(F.lds, (const char*)((F.a->ws) + WS_RA), DM, DM, S, E);
        if (BOTH(5)) SEAM_BAR();
    }
    if (IN(6)) { p5_route(F); if (BOTH(6)) GRID_BAR(); }
    if (IN(7)) {
        moe_table_to_lds(F); MoeSched<false> S; S.init(lds, (F.a->ws) + WS_WUP, (const int*)((F.a->ws) + WS_LIST), F.G, F.vcu, F.tid); EpiMoeUp E{(h16*)((F.a->ws) + WS_H)};
        g8::gemm_phase(F.lds, (const char*)((F.a->ws) + WS_RA), DM, DM, S, E);
        if (BOTH(7)) SEAM_BAR();
    }
    if (IN(8)) {
        if (!IN(7)) moe_table_to_lds(F);
        MoeSched<true> S; S.init(lds, (F.a->ws) + WS_WDN, (const int*)((F.a->ws) + WS_LIST), F.G, F.vcu, F.tid); EpiMoeDown E{(h16*)((F.a->ws) + WS_Y)};
        g8::gemm_phase(F.lds, (const char*)((F.a->ws) + WS_H), DE, DE, S, E);
        if (BOTH(8)) xcd_barrier(bar, true);
    }
    if (IN(9)) { p8_final(F, (F.a->out)); }
#undef IN
#undef BOTH
}

static void launch_mk(void* const* d_in, void* d_out, void* d_ws, hipStream_t stream, int grid, int lo, int hi) {
    Args a{};
    for (int i = 0; i < 20; ++i) a.in[i] = (const float*)d_in[i];
    a.out = (float*)d_out; a.ws = (unsigned char*)d_ws; a.ph_lo = lo; a.ph_hi = hi;
    hipLaunchKernelGGL(mk_fwd, dim3(grid), dim3(NWAVES * 64), LDS_BYTES, stream, a);
}

extern "C" void kernel_launch(void* const* d_in, const int* in_sizes, int n_in, void* d_out, int out_size, void* d_ws, size_t ws_size, hipStream_t stream) {
    static int grid = 0;
    if (grid == 0) {
        if (n_in != 20 || ws_size < WS_END || out_size != M * DM) { fprintf(stderr, "kernel_launch: unexpected n_in %d / ws_size %zu / out_size %d\n", n_in, ws_size, out_size); grid = -1; return; }
        int dev = 0, cus = 0;
        if (hipGetDevice(&dev) != hipSuccess || hipDeviceGetAttribute(&cus, hipDeviceAttributeMultiprocessorCount, dev) != hipSuccess) { grid = -1; return; }
        if (hipFuncSetAttribute((const void*)mk_fwd, hipFuncAttributeMaxDynamicSharedMemorySize, LDS_BYTES) != hipSuccess) { fprintf(stderr, "kernel_launch: hipFuncSetAttribute failed\n"); grid = -1; return; }
        int per_cu = 0;
        if (hipOccupancyMaxActiveBlocksPerMultiprocessor(&per_cu, (const void*)mk_fwd, NWAVES * 64, LDS_BYTES) != hipSuccess || per_cu < 1) { fprintf(stderr, "kernel_launch: the kernel does not fit a CU (occupancy query says %d)\n", per_cu); grid = -1; return; }
        (void)hipGetLastError();
        grid = cus;
    }
    if (grid < 0) return;
    unsigned char* ws = (unsigned char*)d_ws;
    (void)hipMemsetAsync(ws + WS_CTL, 0, CTL_ZERO_BYTES, stream);
    launch_mk(d_in, d_out, d_ws, stream, grid, 0, 10);
}
```
